# Optimizing an MI355X kernel written in HIP

```python
import jax, jax.numpy as jnp
from jax import lax
import numpy as np

D_MODEL = 1024
BATCH = 4
SEQ = 8192
DEPTH = 1

HEAD_DIM = 64
N_Q_HEADS = 8
N_KV_HEADS = 2
Q_PER_KV = N_Q_HEADS // N_KV_HEADS
ATTN_WIDTH = N_Q_HEADS * HEAD_DIM
KV_WIDTH = N_KV_HEADS * HEAD_DIM
WINDOW = 128
BLOCK = 128
ROPE_THETA = 10000.0
CONV_WIDTH = D_MODEL - ATTN_WIDTH
CONV_KSIZE = 3
MIX_WIDTH = ATTN_WIDTH + CONV_WIDTH
IN_COLS = ATTN_WIDTH + 2 * KV_WIDTH + 3 * CONV_WIDTH
D_FF = 2816
FFN_RESIDUAL_WEIGHT = 0.5
MEM_LEN = 256
X_HEADS = 4
X_HEAD_DIM = D_MODEL // X_HEADS

RMS_EPS = 1e-5
NEG_INF = -1e30
MAX_POS_OFFSET = 4096

kernel_name = "hymba_swa_sink_shortconv_macaron_memxattn"


def rms_norm(x, gain):
    xf = x.astype(jnp.float32)
    y = xf * lax.rsqrt(jnp.mean(xf * xf, axis=-1, keepdims=True) + RMS_EPS)
    return (y * gain.astype(jnp.float32)).astype(x.dtype)


def swiglu(u, w_in, w_out):
    gate, up = jnp.split(u @ w_in, 2, axis=-1)
    return (jax.nn.silu(gate) * up) @ w_out


def rope(t, positions):
    half = HEAD_DIM // 2
    inv_freq = ROPE_THETA ** (-jnp.arange(half, dtype=jnp.float32) / half)
    ang = positions.astype(jnp.float32)[..., None] * inv_freq
    cos = jnp.cos(ang)[:, :, None, :]
    sin = jnp.sin(ang)[:, :, None, :]
    tf = t.astype(jnp.float32)
    t1, t2 = tf[..., :half], tf[..., half:]
    out = jnp.concatenate([t1 * cos - t2 * sin, t2 * cos + t1 * sin], axis=-1)
    return out.astype(t.dtype)


def sliding_window_attention(q, k, v, sinks):
    b, s = q.shape[0], q.shape[1]
    nb = s // BLOCK
    qb = q.reshape(b, nb, BLOCK, N_KV_HEADS, Q_PER_KV, HEAD_DIM)
    kb = k.reshape(b, nb, BLOCK, N_KV_HEADS, HEAD_DIM)
    vb = v.reshape(b, nb, BLOCK, N_KV_HEADS, HEAD_DIM)

    def band(t):
        prev = jnp.pad(t, ((0, 0), (1, 0), (0, 0), (0, 0), (0, 0)))[:, :-1]
        return jnp.concatenate([prev, t], axis=2)

    k_band, v_band = band(kb), band(vb)
    scores = jnp.einsum('bnqhgd,bnkhd->bnhgqk', qb, k_band).astype(jnp.float32) * (HEAD_DIM ** -0.5)
    qi = jnp.arange(BLOCK)[:, None]
    ki = jnp.arange(2 * BLOCK)[None, :]
    rel = BLOCK + qi - ki
    in_window = (rel >= 0) & (rel < WINDOW)
    blk = jnp.arange(nb)[:, None, None]
    valid = in_window[None] & ((blk > 0) | (ki[None] >= BLOCK))
    scores = jnp.where(valid[None, :, None, None], scores, NEG_INF)
    sink = sinks.astype(jnp.float32).reshape(N_KV_HEADS, Q_PER_KV)[None, None, :, :, None, None]
    sink = jnp.broadcast_to(sink, scores.shape[:-1] + (1,))
    probs = jax.nn.softmax(jnp.concatenate([scores, sink], axis=-1), axis=-1)[..., :-1]
    out = jnp.einsum('bnhgqk,bnkhd->bnqhgd', probs.astype(v.dtype), v_band)
    return out.reshape(b, s, ATTN_WIDTH)


def short_gated_conv(xc, gate_b, gate_c, conv_w):
    z = gate_c * xc
    rhs = conv_w[:, None, :].astype(z.dtype)
    conv = lax.conv_general_dilated(z, rhs, window_strides=(1,), padding=[(CONV_KSIZE - 1, 0)],
                                    dimension_numbers=('NWC', 'WIO', 'NWC'),
                                    feature_group_count=CONV_WIDTH)
    return gate_b * conv


def memory_cross_attention(u, mem_n, w_xq, w_xkv, w_xo):
    b, s, _ = u.shape
    m = mem_n.shape[1]
    q = (u @ w_xq).reshape(b, s, X_HEADS, X_HEAD_DIM)
    k, v = jnp.split(mem_n @ w_xkv, 2, axis=-1)
    k = k.reshape(b, m, X_HEADS, X_HEAD_DIM)
    v = v.reshape(b, m, X_HEADS, X_HEAD_DIM)
    scores = jnp.einsum('bshd,bmhd->bhsm', q, k).astype(jnp.float32) * (X_HEAD_DIM ** -0.5)
    probs = jax.nn.softmax(scores, axis=-1)
    o = jnp.einsum('bhsm,bmhd->bshd', probs.astype(v.dtype), v).reshape(b, s, D_MODEL)
    return o @ w_xo


def setup_inputs(seed: int = 0) -> dict:
    key = jax.random.key(seed)
    ks = jax.random.split(key, 24)
    f32 = jnp.float32

    def w(k, shape, fan_in):
        return jax.random.normal(k, shape, f32) * (fan_in ** -0.5)

    def gain(k, shape):
        return 1.0 + 0.02 * jax.random.normal(k, shape, f32)

    x = jax.random.normal(ks[0], (BATCH, SEQ, D_MODEL), f32)
    mem = jax.random.normal(ks[1], (BATCH, MEM_LEN, D_MODEL), f32)
    offsets = jax.random.randint(ks[2], (BATCH, 1), 0, MAX_POS_OFFSET, dtype=jnp.int32)
    positions = (jnp.arange(SEQ, dtype=jnp.int32)[None, :] + offsets).astype(jnp.int32)
    return {
        "x": x,
        "mem": mem,
        "positions": positions,
        "g_ffn1": gain(ks[3], (DEPTH, D_MODEL)),
        "w_ffn1_in": w(ks[4], (DEPTH, D_MODEL, 2 * D_FF), D_MODEL),
        "w_ffn1_out": w(ks[5], (DEPTH, D_FF, D_MODEL), D_FF),
        "g_mix": gain(ks[6], (DEPTH, D_MODEL)),
        "w_mix_in": w(ks[7], (DEPTH, D_MODEL, IN_COLS), D_MODEL),
        "sinks": 0.5 * jax.random.normal(ks[8], (DEPTH, N_Q_HEADS), f32),
        "conv_w": w(ks[9], (DEPTH, CONV_KSIZE, CONV_WIDTH), CONV_KSIZE),
        "g_attn_out": gain(ks[10], (DEPTH, ATTN_WIDTH)),
        "g_conv_out": gain(ks[11], (DEPTH, CONV_WIDTH)),
        "w_mix_out": w(ks[12], (DEPTH, MIX_WIDTH, D_MODEL), MIX_WIDTH),
        "g_mem": gain(ks[13], (DEPTH, D_MODEL)),
        "g_xattn": gain(ks[14], (DEPTH, D_MODEL)),
        "w_xq": w(ks[15], (DEPTH, D_MODEL, D_MODEL), D_MODEL),
        "w_xkv": w(ks[16], (DEPTH, D_MODEL, 2 * D_MODEL), D_MODEL),
        "w_xo": w(ks[17], (DEPTH, D_MODEL, D_MODEL), D_MODEL),
        "g_ffn2": gain(ks[18], (DEPTH, D_MODEL)),
        "w_ffn2_in": w(ks[19], (DEPTH, D_MODEL, 2 * D_FF), D_MODEL),
        "w_ffn2_out": w(ks[20], (DEPTH, D_FF, D_MODEL), D_FF),
        "g_final": gain(ks[21], (D_MODEL,)),
    }


def reference(x, mem, positions, g_ffn1, w_ffn1_in, w_ffn1_out, g_mix, w_mix_in, sinks, conv_w,
              g_attn_out, g_conv_out, w_mix_out, g_mem, g_xattn, w_xq, w_xkv, w_xo,
              g_ffn2, w_ffn2_in, w_ffn2_out, g_final):
    b, s, _ = x.shape
    h = x
    for l in range(DEPTH):
        h = h + FFN_RESIDUAL_WEIGHT * swiglu(rms_norm(h, g_ffn1[l]), w_ffn1_in[l], w_ffn1_out[l])

        u = rms_norm(h, g_mix[l])
        proj = u @ w_mix_in[l]
        o0 = ATTN_WIDTH
        o1 = o0 + KV_WIDTH
        o2 = o1 + KV_WIDTH
        o3 = o2 + CONV_WIDTH
        o4 = o3 + CONV_WIDTH
        q = rope(proj[..., :o0].reshape(b, s, N_Q_HEADS, HEAD_DIM), positions)
        k = rope(proj[..., o0:o1].reshape(b, s, N_KV_HEADS, HEAD_DIM), positions)
        v = proj[..., o1:o2].reshape(b, s, N_KV_HEADS, HEAD_DIM)
        gate_b = proj[..., o2:o3]
        gate_c = proj[..., o3:o4]
        xc = proj[..., o4:]

        attn = sliding_window_attention(q, k, v, sinks[l])
        conv = short_gated_conv(xc, gate_b, gate_c, conv_w[l])
        mixed = jnp.concatenate([rms_norm(attn, g_attn_out[l]), rms_norm(conv, g_conv_out[l])], axis=-1)
        h = h + mixed @ w_mix_out[l]

        h = h + memory_cross_attention(rms_norm(h, g_xattn[l]), rms_norm(mem, g_mem[l]),
                                       w_xq[l], w_xkv[l], w_xo[l])

        h = h + FFN_RESIDUAL_WEIGHT * swiglu(rms_norm(h, g_ffn2[l]), w_ffn2_in[l], w_ffn2_out[l])
    return rms_norm(h, g_final)
```

```cpp
#include <hip/hip_runtime.h>
#include <hip/hip_cooperative_groups.h>
#include <cstdio>
#include <cstdint>
#include <cmath>

constexpr int DM = 1024, NB = 4, SEQ = 8192, T = NB * SEQ;
constexpr int HD = 64, NQH = 8, NKVH = 2, AW = 512, KVW = 128, WINDOW = 128, BLK = 128;
constexpr int CW = 512, INC = 2304, DFF = 2816, MEML = 256, XH = 4, XHD = 256, MROWS = NB * MEML;
constexpr float RMS_EPS = 1e-5f;
constexpr float LOG2E = 1.4426950408889634f;
constexpr float QSCALE = 0.125f * LOG2E;
constexpr float XSCALE = 0.0625f * LOG2E;

typedef unsigned short bf16_t;
__host__ __device__ __forceinline__ unsigned f2bf(float f) { unsigned u = __builtin_bit_cast(unsigned, f); return (u + 0x7fffu + ((u >> 16) & 1u)) >> 16; }
__host__ __device__ __forceinline__ float bf2f(unsigned h) { return __builtin_bit_cast(float, (h & 0xffffu) << 16); }

constexpr size_t MiB = 1u << 20;
constexpr size_t WS_CTL = 0;
constexpr size_t WS_W1I = 1 * MiB, WS_W1O = 12 * MiB, WS_WMI = 18 * MiB, WS_WMO = 23 * MiB, WS_WXQ = 25 * MiB, WS_WXKV = 27 * MiB, WS_WXO = 31 * MiB, WS_W2I = 33 * MiB, WS_W2O = 44 * MiB;
constexpr size_t WS_ROPE = 50 * MiB;
constexpr size_t WS_SS = 58 * MiB;
constexpr size_t WS_SSMEM = 68 * MiB;
constexpr size_t WS_GMO = 68 * MiB + 512 * 1024;
constexpr size_t WS_MEMB = 69 * MiB;
constexpr size_t WS_KVM = 71 * MiB;
constexpr size_t WS_HB = 76 * MiB;
constexpr size_t WS_G = 140 * MiB;
constexpr size_t WS_Q = 140 * MiB, WS_K = 172 * MiB, WS_V = 180 * MiB, WS_GB = 188 * MiB, WS_Z = 220 * MiB, WS_MIXED = 252 * MiB;
constexpr size_t WS_XQ = 140 * MiB, WS_XO = 204 * MiB;
constexpr size_t WS_END = 316 * MiB;
constexpr size_t WS_TMP = 316 * MiB;
constexpr size_t WS_NEED = 508 * MiB;
__host__ __device__ __forceinline__ size_t ws_ss(int i) { return WS_SS + (size_t)i * 2 * MiB; }
namespace pg8 {
#define PG8_LAS __attribute__((address_space(3)))
typedef unsigned short bf16_t;
typedef short bf16x8 __attribute__((ext_vector_type(8)));
typedef float f32x4 __attribute__((ext_vector_type(4)));
typedef unsigned u32x4 __attribute__((ext_vector_type(4)));
constexpr int BM = 256, BK = 64, HALF = 128, HTB = HALF * BK * 2  , STAGE_BYTES = 8 * HTB, NXCD = 8, WGM = 8;

__host__ __device__ __forceinline__ int lds_byte(int r, int c) { const int st = (r >> 4) * 2 + (c >> 5), rr = r & 15, cc = c & 31, ob = rr * 64 + cc * 2; return st * 1024 + (ob ^ (((ob >> 9) & 1) << 5)); }
__host__ __device__ __forceinline__ void stage_rc(int b, int& R, int& C) { const int st = b / 1024, sb = b % 1024, swz = sb ^ (((sb >> 9) & 1) << 5); R = (st >> 1) * 16 + swz / 64; C = (st & 1) * 32 + (swz % 64) / 2; }
__host__ __device__ __forceinline__ int perm32(int rho) { const int n = rho >> 4, i = rho & 15; return 8 * (i >> 2) + 4 * n + (i & 3); }

struct Unit { int pm, pn; };
struct Gemm { const bf16_t* A; const bf16_t* Bt; int M, N, K; };

struct StaticOrder {
    int nM, nN, nwg, G, c;
    __host__ __device__ void init(int M, int N, int G_, int c_) { nM = M / BM; nN = N / BM; nwg = nM * nN; G = G_; c = c_; }
    __host__ __device__ bool next(int i, Unit& u) const {
        const long L = (long)i * G + c; if (L >= nwg) return false;
        int wgid = (int)L; { const int q = nwg / NXCD, r = nwg % NXCD, xcd = wgid % NXCD, off = wgid / NXCD; wgid = (xcd < r ? xcd * (q + 1) : r * (q + 1) + (xcd - r) * q) + off; }
        const int nig = WGM * nN, gid = wgid / nig, fm = gid * WGM, gsz = (nM - fm) < WGM ? (nM - fm) : WGM;
        u.pm = fm + ((wgid % nig) % gsz); u.pn = (wgid % nig) / gsz; return true;
    }
    __device__ __forceinline__ void a_ready(const Unit&) const {}
    __device__ __forceinline__ void done(const Unit&) const {}
};
typedef float f32x2c_t __attribute__((ext_vector_type(2))); typedef __bf16 bf16x2c_t __attribute__((ext_vector_type(2)));
__device__ __forceinline__ unsigned cvt_pk_bf16(float lo, float hi) { f32x2c_t v = {lo, hi}; bf16x2c_t b = __builtin_convertvector(v, bf16x2c_t); return __builtin_bit_cast(unsigned, b); }
typedef float f32x2 __attribute__((ext_vector_type(2)));
template <class Epi, class Sched, bool ALIGN_EPI = false, bool SP2 = false>
__device__ __forceinline__ void gemm_phase(PG8_LAS unsigned char* lds, const Gemm g, const Sched& S, const Epi& E) {
    const int tid = threadIdx.x, wid = __builtin_amdgcn_readfirstlane(tid >> 6), lane = tid & 63, wr = wid >> 2, wc = wid & 3, fr = lane & 15, fq = lane >> 4;
    const int K = g.K, nt = K / BK;
    unsigned voffA[2], voffB[2];
#pragma unroll
    for (int i = 0; i < 2; ++i) { int R, C; stage_rc(tid * 16 + i * 8192, R, C); const int Rb = Epi::PERM ? ((R & ~31) + perm32(R & 31)) : R;
        voffA[i] = (unsigned)(R * K + C) * 2u; voffB[i] = (unsigned)(Rb * K + C) * 2u; }
    const size_t kstep = (size_t)(BK * 2);
    const size_t hstep = (size_t)HALF * K * 2;
    const size_t tstep = 2 * hstep;
    const unsigned ldsw = (unsigned)wid * 1024u;
    const int aoff = lds_byte(wr * 64 + fr, fq * 8), boff = lds_byte(wc * 32 + fr, fq * 8);
#define PG8_SA(b, h) (((b) * 2 + (h)) * HTB)
#define PG8_SB(b, h) ((4 + (b) * 2 + (h)) * HTB)
#define PG8_STAGE(bufoff, gbase, voff) do { _Pragma("unroll") for (int _i = 0; _i < 2; ++_i) \
        __builtin_amdgcn_global_load_lds((const unsigned*)((const char*)(gbase) + (voff)[_i]), (PG8_LAS unsigned*)(lds + (bufoff) + ldsw + _i * 8192), 16, 0, 0); } while (0)
#define PG8_LDA(dst, b, h) do { _Pragma("unroll") for (int m = 0; m < 4; ++m) _Pragma("unroll") for (int k = 0; k < 2; ++k) dst[m][k] = *(const PG8_LAS bf16x8*)(lds + PG8_SA(b, h) + aoff + m * 2048 + k * 1024); } while (0)
#define PG8_LDB(dst, b, h) do { _Pragma("unroll") for (int n = 0; n < 2; ++n) _Pragma("unroll") for (int k = 0; k < 2; ++k) dst[n][k] = *(const PG8_LAS bf16x8*)(lds + PG8_SB(b, h) + boff + n * 2048 + k * 1024); } while (0)
#define PG8_MMA(ai, bj, At, Bt) do { __builtin_amdgcn_s_setprio(1); _Pragma("unroll") for (int m = 0; m < 4; ++m) _Pragma("unroll") for (int n = 0; n < 2; ++n) _Pragma("unroll") for (int k = 0; k < 2; ++k) \
        acc[ai][bj][m][n] = __builtin_amdgcn_mfma_f32_16x16x32_bf16(Bt[n][k], At[m][k], acc[ai][bj][m][n], 0, 0, 0); __builtin_amdgcn_s_setprio(0); } while (0)
#define PG8_WAIT_V(n) asm volatile("s_waitcnt vmcnt(" #n ")" ::: "memory")
#define PG8_WAIT_L(n) asm volatile("s_waitcnt lgkmcnt(" #n ")" ::: "memory")
#define PG8_BAR __builtin_amdgcn_s_barrier()
#define PG8_SCHED __builtin_amdgcn_sched_barrier(0)
    Unit cur, nxt; int ui = 0;
    if (!S.next(0, cur)) return;
    f32x4 acc[2][2][4][2];
#pragma unroll
    for (int a = 0; a < 2; ++a)
#pragma unroll
        for (int b = 0; b < 2; ++b)
#pragma unroll
            for (int m = 0; m < 4; ++m)
#pragma unroll
                for (int n = 0; n < 2; ++n) acc[a][b][m][n] = (f32x4){0.f, 0.f, 0.f, 0.f};
    bf16x8 At[4][2], B0[2][2], B1[2][2];
    const char* cA = (const char*)g.A + (size_t)cur.pm * tstep; const char* cB = (const char*)g.Bt + (size_t)cur.pn * tstep;
    S.a_ready(cur);
    if constexpr (SP2) {
        PG8_STAGE(PG8_SB(0, 0), cB, voffB); PG8_STAGE(PG8_SB(0, 1), cB + hstep, voffB); PG8_STAGE(PG8_SA(0, 0), cA, voffA); PG8_STAGE(PG8_SA(0, 1), cA + hstep, voffA);
        if (wr == 1) PG8_BAR;
        PG8_WAIT_V(2); PG8_BAR;
        PG8_STAGE(PG8_SB(1, 0), cB + kstep, voffB); PG8_STAGE(PG8_SA(1, 0), cA + kstep, voffA); PG8_STAGE(PG8_SB(1, 1), cB + hstep + kstep, voffB);
        PG8_WAIT_V(6); PG8_BAR;
    } else {
        PG8_STAGE(PG8_SB(0, 0), cB, voffB); PG8_STAGE(PG8_SA(0, 0), cA, voffA); PG8_STAGE(PG8_SB(0, 1), cB + hstep, voffB); PG8_STAGE(PG8_SA(0, 1), cA + hstep, voffA);
        if (wr == 1) PG8_BAR;
        PG8_WAIT_V(4); PG8_BAR;
        PG8_STAGE(PG8_SB(1, 0), cB + kstep, voffB); PG8_STAGE(PG8_SA(1, 0), cA + kstep, voffA); PG8_STAGE(PG8_SB(1, 1), cB + hstep + kstep, voffB);
        PG8_WAIT_V(6); PG8_BAR;
    }
    for (;;) {
        const bool has_next = S.next(ui + 1, nxt);
        const char* nA = has_next ? (const char*)g.A + (size_t)nxt.pm * tstep : cA; const char* nB = has_next ? (const char*)g.Bt + (size_t)nxt.pn * tstep : cB;
        for (int t = 0; t < nt; t += 2) {
            const bool last = (t == nt - 2);
            const char* a1 = cA + (size_t)(t + 1) * kstep;
            const char* a2 = last ? nA : cA + (size_t)(t + 2) * kstep; const char* b2 = last ? nB : cB + (size_t)(t + 2) * kstep;
            const char* a3 = a2 + kstep; const char* b3 = b2 + kstep;
            if (last && has_next) S.a_ready(nxt);
            if constexpr (SP2) {
            PG8_LDB(B0, 0, 0); PG8_LDB(B1, 0, 1); PG8_SCHED; PG8_LDA(At, 0, 0); PG8_STAGE(PG8_SA(1, 1), a1 + hstep, voffA);
            PG8_WAIT_V(8); PG8_WAIT_L(0); PG8_BAR; PG8_MMA(0, 0, At, B0); PG8_MMA(0, 1, At, B1); PG8_BAR; PG8_SCHED;
            PG8_LDA(At, 0, 1); PG8_STAGE(PG8_SB(0, 0), b2, voffB); PG8_STAGE(PG8_SB(0, 1), b2 + hstep, voffB); PG8_STAGE(PG8_SA(0, 0), a2, voffA);
            PG8_WAIT_V(8); PG8_WAIT_L(0); PG8_BAR; PG8_MMA(1, 0, At, B0); PG8_MMA(1, 1, At, B1); PG8_BAR; PG8_SCHED;
            PG8_LDB(B0, 1, 0); PG8_LDB(B1, 1, 1); PG8_SCHED; PG8_LDA(At, 1, 0); PG8_STAGE(PG8_SA(0, 1), a2 + hstep, voffA);
            PG8_WAIT_V(8); PG8_WAIT_L(0); PG8_BAR; PG8_MMA(0, 0, At, B0); PG8_MMA(0, 1, At, B1); PG8_BAR; PG8_SCHED;
            PG8_LDA(At, 1, 1); PG8_STAGE(PG8_SB(1, 0), b3, voffB); PG8_STAGE(PG8_SB(1, 1), b3 + hstep, voffB); PG8_STAGE(PG8_SA(1, 0), a3, voffA);
            PG8_WAIT_V(8); PG8_WAIT_L(0); PG8_BAR; PG8_MMA(1, 0, At, B0); PG8_MMA(1, 1, At, B1); PG8_BAR; PG8_SCHED;
            } else {
            PG8_LDB(B0, 0, 0); PG8_SCHED; PG8_LDA(At, 0, 0); PG8_STAGE(PG8_SA(1, 1), a1 + hstep, voffA);
            PG8_WAIT_L(8); PG8_BAR; PG8_WAIT_L(0); PG8_MMA(0, 0, At, B0); PG8_BAR; PG8_SCHED;
            PG8_LDB(B1, 0, 1); PG8_STAGE(PG8_SB(0, 0), b2, voffB);
            PG8_BAR; PG8_WAIT_L(0); PG8_MMA(0, 1, At, B1); PG8_BAR;
            PG8_LDA(At, 0, 1); PG8_STAGE(PG8_SA(0, 0), a2, voffA);
            PG8_BAR; PG8_WAIT_L(0); PG8_MMA(1, 0, At, B0); PG8_BAR; PG8_SCHED;
            PG8_STAGE(PG8_SB(0, 1), b2 + hstep, voffB);
            PG8_WAIT_V(6); PG8_BAR; PG8_MMA(1, 1, At, B1); PG8_BAR;
            PG8_LDB(B0, 1, 0); PG8_SCHED; PG8_LDA(At, 1, 0); PG8_STAGE(PG8_SA(0, 1), a2 + hstep, voffA);
            PG8_WAIT_L(8); PG8_BAR; PG8_WAIT_L(0); PG8_MMA(0, 0, At, B0); PG8_BAR; PG8_SCHED;
            PG8_LDB(B1, 1, 1); PG8_STAGE(PG8_SB(1, 0), b3, voffB);
            PG8_BAR; PG8_WAIT_L(0); PG8_MMA(0, 1, At, B1); PG8_BAR;
            PG8_LDA(At, 1, 1); PG8_STAGE(PG8_SA(1, 0), a3, voffA);
            PG8_BAR; PG8_WAIT_L(0); PG8_MMA(1, 0, At, B0); PG8_BAR; PG8_SCHED;
            PG8_STAGE(PG8_SB(1, 1), b3 + hstep, voffB);
            PG8_WAIT_V(6); PG8_BAR; PG8_MMA(1, 1, At, B1); PG8_BAR;
            }
        }
        if constexpr (ALIGN_EPI) { if (wr == 0) PG8_BAR; }
        if constexpr (!Epi::AFTER_DRAIN) { E(acc, cur, wr, wc, fr, fq); S.done(cur); }
        if (!has_next) break;
#pragma unroll
        for (int a = 0; a < 2; ++a)
#pragma unroll
            for (int b = 0; b < 2; ++b)
#pragma unroll
                for (int m = 0; m < 4; ++m)
#pragma unroll
                    for (int n = 0; n < 2; ++n) acc[a][b][m][n] = (f32x4){0.f, 0.f, 0.f, 0.f};
        cur = nxt; cA = nA; cB = nB; ++ui;
        if constexpr (ALIGN_EPI) { if (wr == 1) PG8_BAR; }
    }
    PG8_WAIT_V(0);
    if constexpr (!ALIGN_EPI) { if (wr == 0) PG8_BAR; }
    PG8_BAR;
    if constexpr (Epi::AFTER_DRAIN) { E.fused(acc, cur, wr, wc, fr, fq, lds, wid, lane); S.done(cur); }
#undef PG8_SA
#undef PG8_SB
#undef PG8_STAGE
#undef PG8_LDA
#undef PG8_LDB
#undef PG8_MMA
#undef PG8_WAIT_V
#undef PG8_WAIT_L
#undef PG8_BAR
#undef PG8_SCHED
}

__device__ __forceinline__ float row_rstd(const float* ssp, int row, int fq) {
    const f32x4 p = *(const f32x4*)(ssp + (size_t)row * 16 + 4 * fq);
    float s = (p[0] + p[1]) + (p[2] + p[3]);
    s += __shfl_xor(s, 16); s += __shfl_xor(s, 32);
    return __builtin_amdgcn_rsqf(s * (1.0f / 1024.0f) + 1e-5f);
}
__device__ __forceinline__ u32x4 pack8(const float (&o)[8]) { u32x4 w; w.x = cvt_pk_bf16(o[0], o[1]); w.y = cvt_pk_bf16(o[2], o[3]); w.z = cvt_pk_bf16(o[4], o[5]); w.w = cvt_pk_bf16(o[6], o[7]); return w; }

struct EpiSwiGLU {
    static constexpr bool PERM = true, AFTER_DRAIN = false;
    bf16_t* G; const float* ssp;
    __device__ __forceinline__ void operator()(const f32x4 (&acc)[2][2][4][2], const Unit& u, int wr, int wc, int fr, int fq) const {
        const int row0 = u.pm * BM + wr * 64 + fr, col0 = u.pn * HALF + wc * 32 + 8 * fq;
#pragma unroll
        for (int ai = 0; ai < 2; ++ai)
#pragma unroll
            for (int m = 0; m < 4; ++m) {
                const int row = row0 + ai * HALF + m * 16; const float r = row_rstd(ssp, row, fq); float o[8];
#pragma unroll
                for (int n = 0; n < 2; ++n)
#pragma unroll
                    for (int e = 0; e < 4; ++e) { const float g = acc[ai][0][m][n][e] * r, up = acc[ai][1][m][n][e] * r;
                        o[4 * n + e] = g * __builtin_amdgcn_rcpf(1.0f + __builtin_amdgcn_exp2f(g * -1.4426950408889634f)) * up; }
                *(u32x4*)(G + (size_t)row * 2816 + col0) = pack8(o);
            }
    }
};
struct EpiResid {
    static constexpr bool PERM = true, AFTER_DRAIN = false;
    const float* hin; float* hout; bf16_t* hb; float* ssp; float w;
    __device__ __forceinline__ void operator()(const f32x4 (&acc)[2][2][4][2], const Unit& u, int wr, int wc, int fr, int fq) const {
        const int row0 = u.pm * BM + wr * 64 + fr, col0 = u.pn * BM + wc * 32 + 8 * fq;
#pragma unroll
        for (int ai = 0; ai < 2; ++ai)
#pragma unroll
            for (int m = 0; m < 4; ++m) {
                const int row = row0 + ai * HALF + m * 16; float ss = 0.f;
#pragma unroll
                for (int bj = 0; bj < 2; ++bj) { const size_t off = (size_t)row * 1024 + col0 + bj * HALF;
                    const f32x4 a0 = *(const f32x4*)(hin + off), a1 = *(const f32x4*)(hin + off + 4);
                    const f32x4 v0 = a0 + acc[ai][bj][m][0] * w, v1 = a1 + acc[ai][bj][m][1] * w;
                    *(f32x4*)(hout + off) = v0; *(f32x4*)(hout + off + 4) = v1;
                    u32x4 pk; pk.x = cvt_pk_bf16(v0[0], v0[1]); pk.y = cvt_pk_bf16(v0[2], v0[3]); pk.z = cvt_pk_bf16(v1[0], v1[1]); pk.w = cvt_pk_bf16(v1[2], v1[3]);
                    *(u32x4*)(hb + off) = pk;
                    ss += (v0[0] * v0[0] + v0[1] * v0[1]) + (v0[2] * v0[2] + v0[3] * v0[3]) + (v1[0] * v1[0] + v1[1] * v1[1]) + (v1[2] * v1[2] + v1[3] * v1[3]); }
                ss += __shfl_xor(ss, 16); ss += __shfl_xor(ss, 32);
                if (fq == 0) ssp[(size_t)row * 16 + u.pn * 4 + wc] = ss;
                if (m & 1) asm volatile("" ::: "memory");
            }
    }
};
struct EpiMixIn {
    static constexpr bool PERM = true, AFTER_DRAIN = false;
    const float* ssp; const float* rope; bf16_t* Q; bf16_t* K; bf16_t* V; bf16_t* GB; bf16_t* Z;
    __device__ __forceinline__ void operator()(const f32x4 (&acc)[2][2][4][2], const Unit& u, int wr, int wc, int fr, int fq) const {
        const int row0 = u.pm * BM + wr * 64 + fr, pn = u.pn;
#pragma unroll
        for (int ai = 0; ai < 2; ++ai)
#pragma unroll
            for (int m = 0; m < 4; ++m) {
                const int row = row0 + ai * HALF + m * 16; const float r = row_rstd(ssp, row, fq);
                if (pn < 3) {
                    float t1[8], t2[8];
#pragma unroll
                    for (int n = 0; n < 2; ++n)
#pragma unroll
                        for (int e = 0; e < 4; ++e) { t1[4 * n + e] = acc[ai][0][m][n][e] * r; t2[4 * n + e] = acc[ai][1][m][n][e] * r; }
                    if (pn < 2 || wc < 2) {
                        const f32x4* rp = (const f32x4*)(rope + ((size_t)row * 32 + 8 * fq) * 2);
#pragma unroll
                        for (int i = 0; i < 4; ++i) { const f32x4 cs = rp[i];
                            { const float a = t1[2 * i], b = t2[2 * i]; t1[2 * i] = a * cs[0] - b * cs[1]; t2[2 * i] = b * cs[0] + a * cs[1]; }
                            { const float a = t1[2 * i + 1], b = t2[2 * i + 1]; t1[2 * i + 1] = a * cs[2] - b * cs[3]; t2[2 * i + 1] = b * cs[2] + a * cs[3]; } }
                    }
                    bf16_t* dst; float sc = 1.0f;
                    if (pn < 2) { dst = Q + (size_t)row * 512 + (4 * pn + wc) * 64 + 8 * fq; sc = 0.125f * 1.4426950408889634f; }
                    else if (wc < 2) dst = K + (size_t)row * 128 + wc * 64 + 8 * fq;
                    else dst = V + (size_t)row * 128 + (wc - 2) * 64 + 8 * fq;
#pragma unroll
                    for (int i = 0; i < 8; ++i) { t1[i] *= sc; t2[i] *= sc; }
                    *(u32x4*)dst = pack8(t1); *(u32x4*)(dst + 32) = pack8(t2);
                } else if (pn < 5) {
#pragma unroll
                    for (int bj = 0; bj < 2; ++bj) { float o[8];
#pragma unroll
                        for (int n = 0; n < 2; ++n)
#pragma unroll
                            for (int e = 0; e < 4; ++e) o[4 * n + e] = acc[ai][bj][m][n][e] * r;
                        *(u32x4*)(GB + (size_t)row * 512 + (pn - 3) * 256 + bj * HALF + wc * 32 + 8 * fq) = pack8(o); }
                } else {
                    float o[8];
#pragma unroll
                    for (int n = 0; n < 2; ++n)
#pragma unroll
                        for (int e = 0; e < 4; ++e) o[4 * n + e] = (acc[ai][0][m][n][e] * r) * (acc[ai][1][m][n][e] * r);
                    *(u32x4*)(Z + (size_t)row * 512 + (pn - 5) * HALF + wc * 32 + 8 * fq) = pack8(o);
                }
            }
    }
};
struct EpiScale {
    static constexpr bool PERM = true, AFTER_DRAIN = false;
    bf16_t* O; int ldo; const float* ssp; float scale;
    __device__ __forceinline__ void operator()(const f32x4 (&acc)[2][2][4][2], const Unit& u, int wr, int wc, int fr, int fq) const {
        const int row0 = u.pm * BM + wr * 64 + fr, col0 = u.pn * BM + wc * 32 + 8 * fq;
#pragma unroll
        for (int ai = 0; ai < 2; ++ai)
#pragma unroll
            for (int m = 0; m < 4; ++m) {
                const int row = row0 + ai * HALF + m * 16; const float r = row_rstd(ssp, row, fq) * scale;
#pragma unroll
                for (int bj = 0; bj < 2; ++bj) { float o[8];
#pragma unroll
                    for (int n = 0; n < 2; ++n)
#pragma unroll
                        for (int e = 0; e < 4; ++e) o[4 * n + e] = acc[ai][bj][m][n][e] * r;
                    *(u32x4*)(O + (size_t)row * ldo + col0 + bj * HALF) = pack8(o); }
            }
    }
};
struct ListOrder {
    int idx0, cnt, nN;
    __device__ bool next(int i, Unit& u) const { if (i >= cnt) return false; const int id = idx0 + i; u.pm = id / nN; u.pn = id % nN; return true; }
    __device__ __forceinline__ void a_ready(const Unit&) const {}
    __device__ __forceinline__ void done(const Unit&) const {}
};
}
namespace cg = cooperative_groups;
#define LAS __attribute__((address_space(3)))
typedef unsigned v4u __attribute__((ext_vector_type(4)));
typedef unsigned v2u __attribute__((ext_vector_type(2)));
typedef float f32x4 __attribute__((ext_vector_type(4)));
typedef float f32x16 __attribute__((ext_vector_type(16)));
typedef short bf16x8 __attribute__((ext_vector_type(8)));
typedef short s16x4 __attribute__((ext_vector_type(4)));
#define LDS_WAIT() asm volatile("s_waitcnt lgkmcnt(0)" ::: "memory")
constexpr int NWAVES = 8, NTHR = 512;
constexpr int RING_BYTES = 131072, XTRA_OFF = RING_BYTES, LDS_BYTES = 147456;
constexpr int NPH = 12;

struct Args {
    const float* x; const float* mem; const int* pos; const float* g_ffn1; const float* w_ffn1_in; const float* w_ffn1_out; const float* g_mix; const float* w_mix_in;
    const float* sinks; const float* conv_w; const float* g_attn_out; const float* g_conv_out; const float* w_mix_out; const float* g_mem; const float* g_xattn;
    const float* w_xq; const float* w_xkv; const float* w_xo; const float* g_ffn2; const float* w_ffn2_in; const float* w_ffn2_out; const float* g_final;
    float* out; unsigned char* ws; int ph_lo, ph_hi;
};
__device__ __forceinline__ unsigned pk2(float lo, float hi) { return f2bf(lo) | (f2bf(hi) << 16); }
typedef float f32x2_t __attribute__((ext_vector_type(2))); typedef __bf16 bf16x2_t __attribute__((ext_vector_type(2)));
__device__ __forceinline__ unsigned cvtpk(float lo, float hi) { f32x2_t v = {lo, hi}; bf16x2_t b = __builtin_convertvector(v, bf16x2_t); return __builtin_bit_cast(unsigned, b); }
__device__ __forceinline__ float wave_sum(float v) {
#pragma unroll
    for (int o = 1; o < 64; o <<= 1) v += __shfl_xor(v, o);
    return v;
}
__device__ __forceinline__ int rowmap(int mode, int n0) {
    if (mode == 1) { const int bj = n0 >= DFF ? 1 : 0, jj = n0 - bj * DFF; return 256 * (jj >> 7) + 128 * bj + (jj & 127); }
    if (mode == 2) {
        if (n0 < 512) { const int hd = n0 >> 6, bj = (n0 >> 5) & 1; return 256 * (hd >> 2) + 128 * bj + 32 * (hd & 3); }
        if (n0 < 768) { const int c = n0 - 512, sl = c >> 6, bj = (c >> 5) & 1; return 512 + 128 * bj + 32 * sl; }
        if (n0 < 1280) return n0;
        const int c = n0 - 1280, bj = c >= 512 ? 1 : 0, cc = c - 512 * bj; return 1280 + 256 * (cc >> 7) + 128 * bj + (cc & 127);
    }
    return n0;
}
__device__ __forceinline__ void p0_transpose_item(const float* W, const float* gain, const float* gain2, int K, int N, bf16_t* WT, int mode, LAS float* scr, int item, int lane) {
    const int nblk = N / 32, kb = item / nblk, nb = item % nblk, k0 = 64 * kb, n0 = 32 * nb;
#pragma unroll 8
    for (int i = 0; i < 32; ++i) { const int kk = 2 * i + (lane >> 5), k = k0 + kk; float g = 1.0f; if (gain) g = (gain2 && k >= 512) ? gain2[k - 512] : gain[k];
        scr[kk * 33 + (lane & 31)] = W[(size_t)k * N + n0 + (lane & 31)] * g; }
    LDS_WAIT(); asm volatile("" ::: "memory");
    const int c = lane & 7, r0 = rowmap(mode, n0);
#pragma unroll
    for (int j = 0; j < 4; ++j) { const int n = (lane >> 3) + 8 * j; const LAS float* s = scr + (8 * c) * 33 + n;
        v4u o; o.x = pk2(s[0 * 33], s[1 * 33]); o.y = pk2(s[2 * 33], s[3 * 33]); o.z = pk2(s[4 * 33], s[5 * 33]); o.w = pk2(s[6 * 33], s[7 * 33]);
        *(v4u*)(WT + (size_t)(r0 + n) * K + k0 + 8 * c) = o; }
    LDS_WAIT(); asm volatile("" ::: "memory");
}
__device__ __forceinline__ void stats_row(const float* xrow, bf16_t* orow, float* ssrow, int lane) {
    const f32x4* xr = (const f32x4*)xrow + lane; f32x4 v[4]; float s = 0.f;
#pragma unroll
    for (int j = 0; j < 4; ++j) { v[j] = xr[64 * j]; s += (v[j].x * v[j].x + v[j].y * v[j].y) + (v[j].z * v[j].z + v[j].w * v[j].w); }
    s = wave_sum(s);
    v2u* o8 = (v2u*)orow + lane;
#pragma unroll
    for (int j = 0; j < 4; ++j) { v2u w; w.x = cvtpk(v[j].x, v[j].y); w.y = cvtpk(v[j].z, v[j].w); o8[64 * j] = w; }
    if (lane < 16) ssrow[lane] = lane == 0 ? s : 0.f;
}
__device__ __forceinline__ void phase_prep(const Args& a, LAS unsigned char* lds, int G, int vcu) {
    const int tid = threadIdx.x, lane = tid & 63, wave = __builtin_amdgcn_readfirstlane(tid >> 6);
    LAS float* scr = (LAS float*)(lds + wave * 16384);
    const int gw = vcu * NWAVES + wave, NGW = G * NWAVES;
    unsigned char* ws = a.ws;
    constexpr int I_FI = (DM / 64) * (2 * DFF / 32), I_FO = (DFF / 64) * (DM / 32), I_MI = (DM / 64) * (INC / 32), I_SQ = (DM / 64) * (DM / 32), I_KV = (DM / 64) * (2 * DM / 32);
    constexpr int NITEMS = 2 * I_FI + 2 * I_FO + I_MI + 3 * I_SQ + I_KV;
    for (int it = gw; it < NITEMS; it += NGW) {
        int r = it;
        if (r < I_FI) { p0_transpose_item(a.w_ffn1_in, a.g_ffn1, nullptr, DM, 2 * DFF, (bf16_t*)(ws + WS_W1I), 1, scr, r, lane); continue; } r -= I_FI;
        if (r < I_FI) { p0_transpose_item(a.w_ffn2_in, a.g_ffn2, nullptr, DM, 2 * DFF, (bf16_t*)(ws + WS_W2I), 1, scr, r, lane); continue; } r -= I_FI;
        if (r < I_FO) { p0_transpose_item(a.w_ffn1_out, nullptr, nullptr, DFF, DM, (bf16_t*)(ws + WS_W1O), 0, scr, r, lane); continue; } r -= I_FO;
        if (r < I_FO) { p0_transpose_item(a.w_ffn2_out, nullptr, nullptr, DFF, DM, (bf16_t*)(ws + WS_W2O), 0, scr, r, lane); continue; } r -= I_FO;
        if (r < I_MI) { p0_transpose_item(a.w_mix_in, a.g_mix, nullptr, DM, INC, (bf16_t*)(ws + WS_WMI), 2, scr, r, lane); continue; } r -= I_MI;
        if (r < I_SQ) { p0_transpose_item(a.w_mix_out, a.g_attn_out, a.g_conv_out, DM, DM, (bf16_t*)(ws + WS_WMO), 0, scr, r, lane); continue; } r -= I_SQ;
        if (r < I_SQ) { p0_transpose_item(a.w_xq, a.g_xattn, nullptr, DM, DM, (bf16_t*)(ws + WS_WXQ), 0, scr, r, lane); continue; } r -= I_SQ;
        if (r < I_SQ) { p0_transpose_item(a.w_xo, nullptr, nullptr, DM, DM, (bf16_t*)(ws + WS_WXO), 0, scr, r, lane); continue; } r -= I_SQ;
        p0_transpose_item(a.w_xkv, a.g_mem, nullptr, DM, 2 * DM, (bf16_t*)(ws + WS_WXKV), 0, scr, r, lane);
    }
    for (int m = gw; m < T + MROWS; m += NGW) {
        if (m < T) stats_row(a.x + (size_t)m * DM, (bf16_t*)(ws + WS_HB) + (size_t)m * DM, (float*)(ws + ws_ss(0)) + (size_t)m * 16, lane);
        else { const int r = m - T; stats_row(a.mem + (size_t)r * DM, (bf16_t*)(ws + WS_MEMB) + (size_t)r * DM, (float*)(ws + WS_SSMEM) + (size_t)r * 16, lane); }
    }
    float* rope = (float*)(ws + WS_ROPE);
    for (int i = (vcu * NTHR + tid); i < T * 32; i += G * NTHR) {
        const int row = i >> 5, d = i & 31;
        const double invf = exp2(-(double)d * (13.287712379549449 / 32.0));
        const double ang = (double)a.pos[row] * invf;
        const double kq = rint(ang * 0.15915494309189535); const double y = fma(-kq, 6.283185307179586, ang) - kq * 2.4492935982947064e-16;
        const float yf = (float)y;
        *(float2*)(rope + (size_t)i * 2) = make_float2(cosf(yf), sinf(yf));
    }
}
__device__ __forceinline__ int crow(int r, int hi) { return (r & 3) + 8 * (r >> 2) + 4 * hi; }
__device__ __forceinline__ s16x4 vtr(const LAS unsigned char* p) { typedef short v4i16_t __attribute__((ext_vector_type(4))); return __builtin_bit_cast(s16x4, __builtin_amdgcn_ds_read_tr16_b64_v4i16((LAS v4i16_t*)p)); }
#define MFMA32(A, B, C) __builtin_amdgcn_mfma_f32_32x32x16_bf16((A), (B), (C), 0, 0, 0)
__device__ __forceinline__ f32x16 mfma32z(bf16x8 a, bf16x8 b) { f32x16 r = __builtin_amdgcn_mfma_f32_32x32x16_bf16(a, b, f32x16{}, 0, 0, 0); asm volatile("" : "+v"(r) : "v"(a), "v"(b)); return r; }
__device__ __forceinline__ void phase_swa(const Args& a, LAS unsigned char* lds, int G, int vcu) {
    const int tid = threadIdx.x, lane = tid & 63, r32 = lane & 31, hi = lane >> 5, wid = __builtin_amdgcn_readfirstlane(tid >> 6);
    unsigned char* ws = a.ws;
    const bf16_t* Q = (const bf16_t*)(ws + WS_Q); const bf16_t* Kg = (const bf16_t*)(ws + WS_K); const bf16_t* Vg = (const bf16_t*)(ws + WS_V);
    const bf16_t* GB = (const bf16_t*)(ws + WS_GB); const bf16_t* Z = (const bf16_t*)(ws + WS_Z); bf16_t* MX = (bf16_t*)(ws + WS_MIXED);
    LAS float* SSX = (LAS float*)(lds + XTRA_OFF);
    const float sink2 = a.sinks[wid] * LOG2E;
    const int kvh = wid >> 2;
    for (int unit = vcu; unit < NB * (SEQ / BLK); unit += G) {
        const int b = unit / (SEQ / BLK), blk = unit % (SEQ / BLK); const size_t t0 = (size_t)b * SEQ + (size_t)blk * BLK;
#pragma unroll
        for (int kh = 0; kh < 2; ++kh)
#pragma unroll
            for (int kt = 0; kt < 4; ++kt) {
                v4u kv = (v4u){0u, 0u, 0u, 0u}, vv = (v4u){0u, 0u, 0u, 0u};
                if (blk > 0 || kt >= 2) {
                    const size_t kr = t0 - 128 + 64 * kt;
                    kv = *(const v4u*)(Kg + (kr + lane) * KVW + kh * 64 + wid * 8);
                    vv = *(const v4u*)(Vg + (kr + 16 * (wid & 3) + (lane >> 2)) * KVW + kh * 64 + (wid >> 2) * 32 + (lane & 3) * 8);
                }
                *(LAS v4u*)(lds + (kh * 4 + kt) * 8192 + wid * 1024 + lane * 16) = kv;
                *(LAS v4u*)(lds + 65536 + (kh * 4 + kt) * 8192 + wid * 1024 + lane * 16) = vv;
            }
        __syncthreads();
#pragma unroll
        for (int half = 0; half < 2; ++half) {
        v2u opk[2][2][4];
#pragma unroll
        for (int q2 = 0; q2 < 2; ++q2) { const int qs = 2 * half + q2;
            const bf16_t* Qw = Q + (t0 + 32 * qs + r32) * AW + wid * 64;
            bf16x8 qr[4];
#pragma unroll
            for (int d0 = 0; d0 < 4; ++d0) qr[d0] = *(const bf16x8*)(Qw + d0 * 16 + hi * 8);
            const int T0 = qs >> 1;
            f32x16 p[3][2];
#pragma unroll
            for (int i = 0; i < 3; ++i) {
                const LAS unsigned char* kb = lds + (kvh * 4 + T0 + i) * 8192 + hi * 1024 + r32 * 16;
#pragma unroll
                for (int d0 = 0; d0 < 4; ++d0) {
                    const bf16x8 b0 = *(const LAS bf16x8*)(kb + d0 * 2048), b1 = *(const LAS bf16x8*)(kb + d0 * 2048 + 512);
                    if (d0 == 0) { p[i][0] = mfma32z(b0, qr[0]); p[i][1] = mfma32z(b1, qr[0]); }
                    else { p[i][0] = MFMA32(b0, qr[d0], p[i][0]); p[i][1] = MFMA32(b1, qr[d0], p[i][1]); }
                }
            }
            const int qi = 32 * qs + r32; float mx = sink2;
#pragma unroll
            for (int i = 0; i < 3; ++i)
#pragma unroll
                for (int h2 = 0; h2 < 2; ++h2)
#pragma unroll
                    for (int r = 0; r < 16; ++r) { const int ki = 64 * (T0 + i) + 32 * h2 + crow(r, hi);
                        const bool ok = (ki > qi) && (ki <= qi + 128) && (blk > 0 || ki >= 128);
                        const float s = ok ? p[i][h2][r] : -1e30f; p[i][h2][r] = s; mx = fmaxf(mx, s); }
            mx = fmaxf(mx, __shfl_xor(mx, 32));
            float l = 0.f;
#pragma unroll
            for (int i = 0; i < 3; ++i)
#pragma unroll
                for (int h2 = 0; h2 < 2; ++h2)
#pragma unroll
                    for (int r = 0; r < 16; ++r) { const float e = __builtin_amdgcn_exp2f(p[i][h2][r] - mx); p[i][h2][r] = e; l += e; }
            l += __shfl_xor(l, 32); l += __builtin_amdgcn_exp2f(sink2 - mx);
            const float rl = 1.0f / l;
            f32x16 oT[2];
#pragma unroll
            for (int i = 0; i < 3; ++i) {
                const LAS unsigned char* vp = lds + 65536 + (kvh * 4 + T0 + i) * 8192 + ((lane >> 4) & 1) * 32 + (lane & 3) * 8 + (4 * hi + ((lane & 15) >> 2)) * 64;
#pragma unroll
                for (int ks = 0; ks < 4; ++ks) {
                    const f32x16& ps = p[i][ks >> 1]; const int rb = (ks & 1) * 8;
                    v4u pw; pw.x = cvtpk(ps[rb + 0], ps[rb + 1]); pw.y = cvtpk(ps[rb + 2], ps[rb + 3]); pw.z = cvtpk(ps[rb + 4], ps[rb + 5]); pw.w = cvtpk(ps[rb + 6], ps[rb + 7]);
                    const bf16x8 pf = __builtin_bit_cast(bf16x8, pw);
#pragma unroll
                    for (int d0 = 0; d0 < 2; ++d0) {
                        const s16x4 lo = vtr(vp + d0 * 4096 + ks * 1024), hh = vtr(vp + d0 * 4096 + ks * 1024 + 512);
                        const bf16x8 vf = (bf16x8){lo[0], lo[1], lo[2], lo[3], hh[0], hh[1], hh[2], hh[3]};
                        if (i == 0 && ks == 0) oT[d0] = mfma32z(vf, pf); else oT[d0] = MFMA32(vf, pf, oT[d0]);
                    }
                }
            }
            float ss = 0.f;
#pragma unroll
            for (int d0 = 0; d0 < 2; ++d0)
#pragma unroll
                for (int r = 0; r < 16; ++r) { const float o = oT[d0][r] * rl; oT[d0][r] = o; ss += o * o; }
            ss += __shfl_xor(ss, 32);
            if (hi == 0) SSX[(32 * qs + r32) * 8 + wid] = ss;
#pragma unroll
            for (int d0 = 0; d0 < 2; ++d0)
#pragma unroll
                for (int g = 0; g < 4; ++g) { v2u w; w.x = cvtpk(oT[d0][4 * g], oT[d0][4 * g + 1]); w.y = cvtpk(oT[d0][4 * g + 2], oT[d0][4 * g + 3]); opk[q2][d0][g] = w; }
        }
        __syncthreads();
#pragma unroll
        for (int q2 = 0; q2 < 2; ++q2) { const int qs = 2 * half + q2;
            const f32x4 s0 = *(const LAS f32x4*)(SSX + (32 * qs + r32) * 8), s1 = *(const LAS f32x4*)(SSX + (32 * qs + r32) * 8 + 4);
            const float tot = ((s0[0] + s0[1]) + (s0[2] + s0[3])) + ((s1[0] + s1[1]) + (s1[2] + s1[3]));
            const float ra = __builtin_amdgcn_rsqf(tot * (1.0f / AW) + RMS_EPS);
            bf16_t* dst = MX + (t0 + 32 * qs + r32) * DM + wid * 64 + 4 * hi;
#pragma unroll
            for (int d0 = 0; d0 < 2; ++d0)
#pragma unroll
                for (int g = 0; g < 4; ++g) { const v2u w = opk[q2][d0][g]; v2u o;
                    o.x = cvtpk(bf2f(w.x) * ra, bf2f(w.x >> 16) * ra); o.y = cvtpk(bf2f(w.y) * ra, bf2f(w.y >> 16) * ra);
                    *(v2u*)(dst + 32 * d0 + 8 * g) = o; }
        }
        }
        {
            const int c0 = 8 * lane; float cw[3][8];
#pragma unroll
            for (int j = 0; j < 3; ++j) { const f32x4 w0 = *(const f32x4*)(a.conv_w + j * CW + c0), w1 = *(const f32x4*)(a.conv_w + j * CW + c0 + 4);
                cw[j][0] = w0[0]; cw[j][1] = w0[1]; cw[j][2] = w0[2]; cw[j][3] = w0[3]; cw[j][4] = w1[0]; cw[j][5] = w1[1]; cw[j][6] = w1[2]; cw[j][7] = w1[3]; }
            const size_t tw = t0 + 16 * wid; const int s0 = blk * BLK + 16 * wid;
            v4u z2 = (v4u){0u, 0u, 0u, 0u}, z1 = (v4u){0u, 0u, 0u, 0u};
            if (s0 >= 2) z2 = *(const v4u*)(Z + (tw - 2) * CW + c0);
            if (s0 >= 1) z1 = *(const v4u*)(Z + (tw - 1) * CW + c0);
            for (int tt = 0; tt < 16; ++tt) {
                const v4u z0 = *(const v4u*)(Z + (tw + tt) * CW + c0), gb = *(const v4u*)(GB + (tw + tt) * CW + c0);
                float y[8]; float ss = 0.f;
#pragma unroll
                for (int e = 0; e < 4; ++e) {
                    const unsigned a2 = z2[e], a1 = z1[e], a0 = z0[e], gg = gb[e];
                    const float ylo = (cw[0][2 * e] * bf2f(a2) + cw[1][2 * e] * bf2f(a1) + cw[2][2 * e] * bf2f(a0)) * bf2f(gg);
                    const float yhi = (cw[0][2 * e + 1] * bf2f(a2 >> 16) + cw[1][2 * e + 1] * bf2f(a1 >> 16) + cw[2][2 * e + 1] * bf2f(a0 >> 16)) * bf2f(gg >> 16);
                    y[2 * e] = ylo; y[2 * e + 1] = yhi; ss += ylo * ylo + yhi * yhi;
                }
                ss = wave_sum(ss); const float rc = __builtin_amdgcn_rsqf(ss * (1.0f / CW) + RMS_EPS);
                v4u o; o.x = cvtpk(y[0] * rc, y[1] * rc); o.y = cvtpk(y[2] * rc, y[3] * rc); o.z = cvtpk(y[4] * rc, y[5] * rc); o.w = cvtpk(y[6] * rc, y[7] * rc);
                *(v4u*)(MX + (tw + tt) * DM + AW + c0) = o;
                z2 = z1; z1 = z0;
            }
        }
        __syncthreads();
    }
}
__device__ __forceinline__ void phase_xattn(const Args& a, LAS unsigned char* lds, int G, int vcu) {
    const int tid0 = threadIdx.x, wid = __builtin_amdgcn_readfirstlane(tid0 >> 6);
    unsigned char* ws = a.ws;
    const bf16_t* XQ = (const bf16_t*)(ws + WS_XQ); const bf16_t* KVM = (const bf16_t*)(ws + WS_KVM); bf16_t* XO = (bf16_t*)(ws + WS_XO);
    for (int unit = vcu; unit < (T / 256) * XH; unit += G) {
        int tid = tid0; asm volatile("" : "+v"(tid));
        const int lane = tid & 63, r32 = lane & 31, hi = lane >> 5;
        const int pm = unit / XH, h = unit % XH; const size_t t0 = (size_t)pm * 256; const int b = (int)(t0 / SEQ);
        const bf16_t* Kh = KVM + (size_t)(b * MEML) * 2 * DM + h * XHD; const bf16_t* Vh = Kh + DM;
        {   const int mq = tid >> 5, c = tid & 31;
            const unsigned loff = (unsigned)(mq * (2 * DM * 2) + c * 16);
            LAS unsigned char* d0p = lds + mq * 512 + ((c ^ mq) << 4); LAS unsigned char* d1p = lds + mq * 512 + (((c ^ mq) ^ 16) << 4);
#pragma unroll
            for (int i = 0; i < 16; ++i) { const char* bp = (const char*)Kh + (size_t)i * (16 * 2 * DM * 2); asm volatile("" : "+s"(bp)); const v4u v = *(const v4u*)(bp + loff); *(LAS v4u*)(((i & 1) ? d1p : d0p) + i * 8192) = v; } }
        const bf16_t* Qw = XQ + (t0 + 32 * wid + r32) * DM + h * XHD + hi * 8;
        __syncthreads();
        v4u pw[16]; float l = 0.f, m_run = -1e30f, f0 = 1.0f;
#pragma unroll
        for (int ps = 0; ps < 2; ++ps) {
            __builtin_amdgcn_sched_barrier(0);
            bf16x8 qc[4], qn[4];
#pragma unroll
            for (int dd = 0; dd < 4; ++dd) qc[dd] = *(const bf16x8*)(Qw + dd * 16);
            f32x16 p[4];
#pragma unroll
            for (int g = 0; g < 4; ++g) {
                if (g < 3) {
#pragma unroll
                    for (int dd = 0; dd < 4; ++dd) qn[dd] = *(const bf16x8*)(Qw + (4 * g + 4 + dd) * 16);
                }
#pragma unroll
                for (int dd = 0; dd < 4; ++dd) {
                    const int d0 = 4 * g + dd; unsigned ab = (unsigned)(ps * 65536 + r32 * 512 + (((2 * d0 + hi) ^ r32) << 4));
                    asm volatile("" : "+v"(ab));
#pragma unroll
                    for (int j = 0; j < 4; ++j) { const bf16x8 kf = *(const LAS bf16x8*)(lds + ab + j * 16384); if (d0 == 0) p[j] = mfma32z(kf, qc[0]); else p[j] = MFMA32(kf, qc[dd], p[j]); }
                }
                __builtin_amdgcn_sched_barrier(0);
#pragma unroll
                for (int dd = 0; dd < 4; ++dd) qc[dd] = qn[dd];
            }
            __builtin_amdgcn_sched_barrier(0);
            float mx = -1e30f;
#pragma unroll
            for (int j = 0; j < 4; ++j)
#pragma unroll
                for (int r = 0; r < 16; ++r) mx = fmaxf(mx, p[j][r]);
            mx = fmaxf(mx, __shfl_xor(mx, 32));
            const float mnew = fmaxf(m_run, mx);
            if (ps == 1) { f0 = __builtin_amdgcn_exp2f(m_run - mnew); l *= f0; }
            m_run = mnew;
            float ls = 0.f;
#pragma unroll
            for (int j = 0; j < 4; ++j) {
#pragma unroll
                for (int r = 0; r < 16; ++r) { const float e = __builtin_amdgcn_exp2f(p[j][r] - mnew); p[j][r] = e; ls += e; }
                v4u w0, w1;
                w0.x = cvtpk(p[j][0], p[j][1]); w0.y = cvtpk(p[j][2], p[j][3]); w0.z = cvtpk(p[j][4], p[j][5]); w0.w = cvtpk(p[j][6], p[j][7]);
                w1.x = cvtpk(p[j][8], p[j][9]); w1.y = cvtpk(p[j][10], p[j][11]); w1.z = cvtpk(p[j][12], p[j][13]); w1.w = cvtpk(p[j][14], p[j][15]);
                pw[8 * ps + 2 * j] = w0; pw[8 * ps + 2 * j + 1] = w1;
                __builtin_amdgcn_sched_barrier(0);
            }
            l += ls;
            __builtin_amdgcn_sched_barrier(0);
        }
        l += __shfl_xor(l, 32); const float rl = 1.0f / l;
        __syncthreads();
        {   const int mq = tid >> 5, c = tid & 31;
            const unsigned loff = (unsigned)(mq * (2 * DM * 2) + c * 16); LAS unsigned char* dp = lds + (c >> 2) * 16384 + mq * 64 + (c & 3) * 16;
#pragma unroll
            for (int i = 0; i < 16; ++i) { const char* bp = (const char*)Vh + (size_t)i * (16 * 2 * DM * 2); asm volatile("" : "+s"(bp)); const v4u v = *(const v4u*)(bp + loff); *(LAS v4u*)(dp + i * 1024) = v; } }
        __syncthreads();
        const LAS unsigned char* vp = lds + ((lane >> 4) & 1) * 32 + (lane & 3) * 8 + (4 * hi + ((lane & 15) >> 2)) * 64;
        bf16_t* dst = XO + (t0 + 32 * wid + r32) * DM + h * XHD + 4 * hi;
#pragma unroll
        for (int db = 0; db < 8; ++db) {
            f32x16 o;
            unsigned vb = (unsigned)(db * 16384); asm volatile("" : "+v"(vb));
#pragma unroll
            for (int ks = 0; ks < 16; ++ks) {
                const s16x4 lo = vtr(vp + vb + ks * 1024), hh = vtr(vp + vb + ks * 1024 + 512);
                const bf16x8 vf = (bf16x8){lo[0], lo[1], lo[2], lo[3], hh[0], hh[1], hh[2], hh[3]};
                if (ks == 0) o = mfma32z(vf, __builtin_bit_cast(bf16x8, pw[0])); else o = MFMA32(vf, __builtin_bit_cast(bf16x8, pw[ks]), o);
                if (ks == 7) {
#pragma unroll
                    for (int r = 0; r < 16; ++r) o[r] *= f0;
                }
            }
#pragma unroll
            for (int g = 0; g < 4; ++g) { v2u w; w.x = cvtpk(o[4 * g] * rl, o[4 * g + 1] * rl); w.y = cvtpk(o[4 * g + 2] * rl, o[4 * g + 3] * rl); *(v2u*)(dst + 32 * db + 8 * g) = w; }
        }
        __syncthreads();
    }
}
__device__ __forceinline__ void phase_final(const Args& a, int G, int vcu) {
    const int tid = threadIdx.x, lane = tid & 63, wave = tid >> 6;
    const float* ssp = (const float*)(a.ws + ws_ss(4));
    f32x4 gv[4];
#pragma unroll
    for (int j = 0; j < 4; ++j) gv[j] = ((const f32x4*)a.g_final)[lane + 64 * j];
    for (int m = vcu * NWAVES + wave; m < T; m += G * NWAVES) {
        const f32x4 p0 = *(const f32x4*)(ssp + (size_t)m * 16), p1 = *(const f32x4*)(ssp + (size_t)m * 16 + 4), p2 = *(const f32x4*)(ssp + (size_t)m * 16 + 8), p3 = *(const f32x4*)(ssp + (size_t)m * 16 + 12);
        const float s = (((p0[0] + p0[1]) + (p0[2] + p0[3])) + ((p1[0] + p1[1]) + (p1[2] + p1[3]))) + (((p2[0] + p2[1]) + (p2[2] + p2[3])) + ((p3[0] + p3[1]) + (p3[2] + p3[3])));
        const float r = 1.0f / sqrtf(s * (1.0f / DM) + RMS_EPS);
        f32x4* row = (f32x4*)(a.out + (size_t)m * DM) + lane;
#pragma unroll
        for (int j = 0; j < 4; ++j) row[64 * j] = row[64 * j] * r * gv[j];
    }
}
__global__ void __launch_bounds__(NTHR, 2) mk_fwd(Args a) {
    extern __shared__ __attribute__((aligned(16))) unsigned char lds_raw[];
    LAS unsigned char* lds = (LAS unsigned char*)lds_raw;
    const int G = gridDim.x, bx = blockIdx.x, vcu = (G % 8 == 0) ? (bx % 8) * (G / 8) + bx / 8 : bx;
    unsigned char* ws = a.ws;
    const int lo = a.ph_lo, hi = a.ph_hi;
#ifndef PHMASK
#define PHMASK 0xFFF
#endif
#define IN(k) (((PHMASK >> (k)) & 1) && lo <= (k) && (k) < hi)
#define SEAM(k) do { if (IN(k) && IN((k) + 1)) cg::this_grid().sync(); } while (0)
    if (IN(0)) phase_prep(a, lds, G, vcu);
    SEAM(0);
    if (IN(1)) { pg8::Gemm g{(const bf16_t*)(ws + WS_HB), (const bf16_t*)(ws + WS_W1I), T, 2 * DFF, DM}; pg8::StaticOrder S; S.init(T, 2 * DFF, G, bx);
        pg8::EpiSwiGLU E{(bf16_t*)(ws + WS_G), (const float*)(ws + ws_ss(0))};
        pg8::gemm_phase<pg8::EpiSwiGLU, pg8::StaticOrder, true, true>(lds, g, S, E); }
    SEAM(1);
    if (IN(2)) { pg8::Gemm g{(const bf16_t*)(ws + WS_G), (const bf16_t*)(ws + WS_W1O), T, DM, DFF}; pg8::StaticOrder S; S.init(T, DM, G, bx);
        pg8::EpiResid E{a.x, a.out, (bf16_t*)(ws + WS_HB), (float*)(ws + ws_ss(1)), 0.5f};
        pg8::gemm_phase<pg8::EpiResid, pg8::StaticOrder, true, true>(lds, g, S, E); }
    SEAM(2);
    if (IN(3)) {
        { pg8::Gemm g{(const bf16_t*)(ws + WS_HB), (const bf16_t*)(ws + WS_WMI), T, INC, DM}; pg8::StaticOrder S; S.init(T, INC, G, bx);
          pg8::EpiMixIn E{(const float*)(ws + ws_ss(1)), (const float*)(ws + WS_ROPE), (bf16_t*)(ws + WS_Q), (bf16_t*)(ws + WS_K), (bf16_t*)(ws + WS_V), (bf16_t*)(ws + WS_GB), (bf16_t*)(ws + WS_Z)};
          pg8::gemm_phase<pg8::EpiMixIn, pg8::StaticOrder, true, true>(lds, g, S, E); }
        { int idx0, cnt;
          if (G == 256) { idx0 = bx - 128; cnt = (bx >= 128 && bx < 160) ? 1 : 0; }
          else { const int per = (32 + G - 1) / G; idx0 = bx * per; cnt = idx0 >= 32 ? 0 : (idx0 + per <= 32 ? per : 32 - idx0); }
          pg8::ListOrder S{idx0, cnt, 8};
          pg8::Gemm g{(const bf16_t*)(ws + WS_MEMB), (const bf16_t*)(ws + WS_WXKV), MROWS, 2 * DM, DM};
          pg8::EpiScale E{(bf16_t*)(ws + WS_KVM), 2 * DM, (const float*)(ws + WS_SSMEM), 1.0f};
          pg8::gemm_phase<pg8::EpiScale, pg8::ListOrder, true, true>(lds, g, S, E); }
    }
    SEAM(3);
    if (IN(4)) phase_swa(a, lds, G, vcu);
    SEAM(4);
    if (IN(5)) { pg8::Gemm g{(const bf16_t*)(ws + WS_MIXED), (const bf16_t*)(ws + WS_WMO), T, DM, DM}; pg8::StaticOrder S; S.init(T, DM, G, bx);
        pg8::EpiResid E{a.out, a.out, (bf16_t*)(ws + WS_HB), (float*)(ws + ws_ss(2)), 1.0f};
        pg8::gemm_phase<pg8::EpiResid, pg8::StaticOrder, true, true>(lds, g, S, E); }
    SEAM(5);
    if (IN(6)) { pg8::Gemm g{(const bf16_t*)(ws + WS_HB), (const bf16_t*)(ws + WS_WXQ), T, DM, DM}; pg8::StaticOrder S; S.init(T, DM, G, bx);
        pg8::EpiScale E{(bf16_t*)(ws + WS_XQ), DM, (const float*)(ws + ws_ss(2)), XSCALE};
        pg8::gemm_phase<pg8::EpiScale, pg8::StaticOrder, true, true>(lds, g, S, E); }
    SEAM(6);
    if (IN(7)) phase_xattn(a, lds, G, vcu);
    SEAM(7);
    if (IN(8)) { pg8::Gemm g{(const bf16_t*)(ws + WS_XO), (const bf16_t*)(ws + WS_WXO), T, DM, DM}; pg8::StaticOrder S; S.init(T, DM, G, bx);
        pg8::EpiResid E{a.out, a.out, (bf16_t*)(ws + WS_HB), (float*)(ws + ws_ss(3)), 1.0f};
        pg8::gemm_phase<pg8::EpiResid, pg8::StaticOrder, true, true>(lds, g, S, E); }
    SEAM(8);
    if (IN(9)) { pg8::Gemm g{(const bf16_t*)(ws + WS_HB), (const bf16_t*)(ws + WS_W2I), T, 2 * DFF, DM}; pg8::StaticOrder S; S.init(T, 2 * DFF, G, bx);
        pg8::EpiSwiGLU E{(bf16_t*)(ws + WS_G), (const float*)(ws + ws_ss(3))};
        pg8::gemm_phase<pg8::EpiSwiGLU, pg8::StaticOrder, true, true>(lds, g, S, E); }
    SEAM(9);
    if (IN(10)) { pg8::Gemm g{(const bf16_t*)(ws + WS_G), (const bf16_t*)(ws + WS_W2O), T, DM, DFF}; pg8::StaticOrder S; S.init(T, DM, G, bx);
        pg8::EpiResid E{a.out, a.out, (bf16_t*)(ws + WS_HB), (float*)(ws + ws_ss(4)), 0.5f};
        pg8::gemm_phase<pg8::EpiResid, pg8::StaticOrder, true, true>(lds, g, S, E); }
    SEAM(10);
    if (IN(11)) phase_final(a, G, vcu);
#undef IN
#undef SEAM
}
static void fill_args(Args& a, void* const* d_in, void* d_out, void* d_ws) {
    a.x = (const float*)d_in[0]; a.mem = (const float*)d_in[1]; a.pos = (const int*)d_in[2]; a.g_ffn1 = (const float*)d_in[3]; a.w_ffn1_in = (const float*)d_in[4]; a.w_ffn1_out = (const float*)d_in[5];
    a.g_mix = (const float*)d_in[6]; a.w_mix_in = (const float*)d_in[7]; a.sinks = (const float*)d_in[8]; a.conv_w = (const float*)d_in[9]; a.g_attn_out = (const float*)d_in[10]; a.g_conv_out = (const float*)d_in[11];
    a.w_mix_out = (const float*)d_in[12]; a.g_mem = (const float*)d_in[13]; a.g_xattn = (const float*)d_in[14]; a.w_xq = (const float*)d_in[15]; a.w_xkv = (const float*)d_in[16]; a.w_xo = (const float*)d_in[17];
    a.g_ffn2 = (const float*)d_in[18]; a.w_ffn2_in = (const float*)d_in[19]; a.w_ffn2_out = (const float*)d_in[20]; a.g_final = (const float*)d_in[21];
    a.out = (float*)d_out; a.ws = (unsigned char*)d_ws;
}
extern "C" void kernel_launch(void* const* d_in, const int* in_sizes, int n_in, void* d_out, int out_size, void* d_ws, size_t ws_size, hipStream_t stream) {
    if (n_in != 22 || out_size != T * DM || ws_size < WS_END) { fprintf(stderr, "kernel_launch: unexpected shapes (n_in %d out %d ws %zu)\n", n_in, out_size, ws_size); return; }
    static int grid = 0;
    if (grid == 0) {
        int dev = 0, cus = 0, per_cu = 0;
        if (hipFuncSetAttribute((const void*)mk_fwd, hipFuncAttributeMaxDynamicSharedMemorySize, LDS_BYTES) != hipSuccess) { fprintf(stderr, "kernel_launch: hipFuncSetAttribute failed\n"); grid = -1; return; }
        if (hipGetDevice(&dev) != hipSuccess || hipDeviceGetAttribute(&cus, hipDeviceAttributeMultiprocessorCount, dev) != hipSuccess) { fprintf(stderr, "kernel_launch: device query failed\n"); grid = -1; return; }
        if (hipOccupancyMaxActiveBlocksPerMultiprocessor(&per_cu, (const void*)mk_fwd, NTHR, LDS_BYTES) != hipSuccess || per_cu < 1) { fprintf(stderr, "kernel_launch: occupancy query says %d blocks per CU\n", per_cu); grid = -1; return; }
        grid = cus;
    }
    if (grid < 0) return;
    Args a{}; fill_args(a, d_in, d_out, d_ws); a.ph_lo = 0; a.ph_hi = NPH;
    void* args[] = {&a};
    const hipError_t e = hipLaunchCooperativeKernel((const void*)mk_fwd, dim3(grid), dim3(NTHR), args, LDS_BYTES, stream);
    if (e != hipSuccess) fprintf(stderr, "kernel_launch: cooperative launch failed: %s (grid %d)\n", hipGetErrorString(e), grid);
}
```

```cpp
#include <hip/hip_runtime.h>
#include <hip/hip_cooperative_groups.h>
#include <cstdio>
#include <cstdint>
#include <cmath>

constexpr int DM = 1024, NB = 4, SEQ = 8192, T = NB * SEQ;
constexpr int HD = 64, NQH = 8, NKVH = 2, AW = 512, KVW = 128, WINDOW = 128, BLK = 128;
constexpr int CW = 512, INC = 2304, DFF = 2816, MEML = 256, XH = 4, XHD = 256, MROWS = NB * MEML;
constexpr float RMS_EPS = 1e-5f;
constexpr float LOG2E = 1.4426950408889634f;
constexpr float QSCALE = 0.125f * LOG2E;
constexpr float XSCALE = 0.0625f * LOG2E;

typedef unsigned short bf16_t;
__host__ __device__ __forceinline__ unsigned f2bf(float f) { unsigned u = __builtin_bit_cast(unsigned, f); return (u + 0x7fffu + ((u >> 16) & 1u)) >> 16; }
__host__ __device__ __forceinline__ float bf2f(unsigned h) { return __builtin_bit_cast(float, (h & 0xffffu) << 16); }

constexpr size_t MiB = 1u << 20;
constexpr size_t WS_CTL = 0;
constexpr size_t WS_W1I = 1 * MiB, WS_W1O = 12 * MiB, WS_WMI = 18 * MiB, WS_WMO = 23 * MiB, WS_WXQ = 25 * MiB, WS_WXKV = 27 * MiB, WS_WXO = 31 * MiB, WS_W2I = 33 * MiB, WS_W2O = 44 * MiB;
constexpr size_t WS_ROPE = 50 * MiB;
constexpr size_t WS_SS = 58 * MiB;
constexpr size_t WS_SSMEM = 68 * MiB;
constexpr size_t WS_GMO = 68 * MiB + 512 * 1024;
constexpr size_t WS_MEMB = 69 * MiB;
constexpr size_t WS_KVM = 71 * MiB;
constexpr size_t WS_HB = 76 * MiB;
constexpr size_t WS_G = 140 * MiB;
constexpr size_t WS_Q = 140 * MiB, WS_K = 172 * MiB, WS_V = 180 * MiB, WS_GB = 188 * MiB, WS_Z = 220 * MiB, WS_MIXED = 252 * MiB;
constexpr size_t WS_XQ = 140 * MiB, WS_XO = 204 * MiB;
constexpr size_t WS_END = 316 * MiB;
constexpr size_t WS_TMP = 316 * MiB;
constexpr size_t WS_NEED = 508 * MiB;
__host__ __device__ __forceinline__ size_t ws_ss(int i) { return WS_SS + (size_t)i * 2 * MiB; }
namespace pg8 {
#define PG8_LAS __attribute__((address_space(3)))
typedef unsigned short bf16_t;
typedef short bf16x8 __attribute__((ext_vector_type(8)));
typedef float f32x4 __attribute__((ext_vector_type(4)));
typedef unsigned u32x4 __attribute__((ext_vector_type(4)));
constexpr int BM = 256, BK = 64, HALF = 128, HTB = HALF * BK * 2  , STAGE_BYTES = 8 * HTB, NXCD = 8, WGM = 8;

__host__ __device__ __forceinline__ int lds_byte(int r, int c) { const int st = (r >> 4) * 2 + (c >> 5), rr = r & 15, cc = c & 31, ob = rr * 64 + cc * 2; return st * 1024 + (ob ^ (((ob >> 9) & 1) << 5)); }
__host__ __device__ __forceinline__ void stage_rc(int b, int& R, int& C) { const int st = b / 1024, sb = b % 1024, swz = sb ^ (((sb >> 9) & 1) << 5); R = (st >> 1) * 16 + swz / 64; C = (st & 1) * 32 + (swz % 64) / 2; }
__host__ __device__ __forceinline__ int perm32(int rho) { const int n = rho >> 4, i = rho & 15; return 8 * (i >> 2) + 4 * n + (i & 3); }

struct Unit { int pm, pn; };
struct Gemm { const bf16_t* A; const bf16_t* Bt; int M, N, K; };

struct StaticOrder {
    int nM, nN, nwg, G, c;
    __host__ __device__ void init(int M, int N, int G_, int c_) { nM = M / BM; nN = N / BM; nwg = nM * nN; G = G_; c = c_; }
    __host__ __device__ bool next(int i, Unit& u) const {
        const long L = (long)i * G + c; if (L >= nwg) return false;
        int wgid = (int)L; { const int q = nwg / NXCD, r = nwg % NXCD, xcd = wgid % NXCD, off = wgid / NXCD; wgid = (xcd < r ? xcd * (q + 1) : r * (q + 1) + (xcd - r) * q) + off; }
        const int nig = WGM * nN, gid = wgid / nig, fm = gid * WGM, gsz = (nM - fm) < WGM ? (nM - fm) : WGM;
        u.pm = fm + ((wgid % nig) % gsz); u.pn = (wgid % nig) / gsz; return true;
    }
    __device__ __forceinline__ void a_ready(const Unit&) const {}
    __device__ __forceinline__ void done(const Unit&) const {}
};
typedef float f32x2c_t __attribute__((ext_vector_type(2))); typedef __bf16 bf16x2c_t __attribute__((ext_vector_type(2)));
__device__ __forceinline__ unsigned cvt_pk_bf16(float lo, float hi) { f32x2c_t v = {lo, hi}; bf16x2c_t b = __builtin_convertvector(v, bf16x2c_t); return __builtin_bit_cast(unsigned, b); }
typedef float f32x2 __attribute__((ext_vector_type(2)));
template <class Epi, class Sched, bool ALIGN_EPI = false, bool SP2 = false>
__device__ __forceinline__ void gemm_phase(PG8_LAS unsigned char* lds, const Gemm g, const Sched& S, const Epi& E) {
    const int tid = threadIdx.x, wid = __builtin_amdgcn_readfirstlane(tid >> 6), lane = tid & 63, wr = wid >> 2, wc = wid & 3, fr = lane & 15, fq = lane >> 4;
    const int K = g.K, nt = K / BK;
    unsigned voffA[2], voffB[2];
#pragma unroll
    for (int i = 0; i < 2; ++i) { int R, C; stage_rc(tid * 16 + i * 8192, R, C); const int Rb = Epi::PERM ? ((R & ~31) + perm32(R & 31)) : R;
        voffA[i] = (unsigned)(R * K + C) * 2u; voffB[i] = (unsigned)(Rb * K + C) * 2u; }
    const size_t kstep = (size_t)(BK * 2);
    const size_t hstep = (size_t)HALF * K * 2;
    const size_t tstep = 2 * hstep;
    const unsigned ldsw = (unsigned)wid * 1024u;
    const int aoff = lds_byte(wr * 64 + fr, fq * 8), boff = lds_byte(wc * 32 + fr, fq * 8);
#define PG8_SA(b, h) (((b) * 2 + (h)) * HTB)
#define PG8_SB(b, h) ((4 + (b) * 2 + (h)) * HTB)
#define PG8_STAGE(bufoff, gbase, voff) do { _Pragma("unroll") for (int _i = 0; _i < 2; ++_i) \
        __builtin_amdgcn_global_load_lds((const unsigned*)((const char*)(gbase) + (voff)[_i]), (PG8_LAS unsigned*)(lds + (bufoff) + ldsw + _i * 8192), 16, 0, 0); } while (0)
#define PG8_LDA(dst, b, h) do { _Pragma("unroll") for (int m = 0; m < 4; ++m) _Pragma("unroll") for (int k = 0; k < 2; ++k) dst[m][k] = *(const PG8_LAS bf16x8*)(lds + PG8_SA(b, h) + aoff + m * 2048 + k * 1024); } while (0)
#define PG8_LDB(dst, b, h) do { _Pragma("unroll") for (int n = 0; n < 2; ++n) _Pragma("unroll") for (int k = 0; k < 2; ++k) dst[n][k] = *(const PG8_LAS bf16x8*)(lds + PG8_SB(b, h) + boff + n * 2048 + k * 1024); } while (0)
#define PG8_MMA(ai, bj, At, Bt) do { __builtin_amdgcn_s_setprio(1); _Pragma("unroll") for (int m = 0; m < 4; ++m) _Pragma("unroll") for (int n = 0; n < 2; ++n) _Pragma("unroll") for (int k = 0; k < 2; ++k) \
        acc[ai][bj][m][n] = __builtin_amdgcn_mfma_f32_16x16x32_bf16(Bt[n][k], At[m][k], acc[ai][bj][m][n], 0, 0, 0); __builtin_amdgcn_s_setprio(0); } while (0)
#define PG8_WAIT_V(n) asm volatile("s_waitcnt vmcnt(" #n ")" ::: "memory")
#define PG8_WAIT_L(n) asm volatile("s_waitcnt lgkmcnt(" #n ")" ::: "memory")
#define PG8_BAR __builtin_amdgcn_s_barrier()
#define PG8_SCHED __builtin_amdgcn_sched_barrier(0)
    Unit cur, nxt; int ui = 0;
    if (!S.next(0, cur)) return;
    f32x4 acc[2][2][4][2];
#pragma unroll
    for (int a = 0; a < 2; ++a)
#pragma unroll
        for (int b = 0; b < 2; ++b)
#pragma unroll
            for (int m = 0; m < 4; ++m)
#pragma unroll
                for (int n = 0; n < 2; ++n) acc[a][b][m][n] = (f32x4){0.f, 0.f, 0.f, 0.f};
    bf16x8 At[4][2], B0[2][2], B1[2][2];
    const char* cA = (const char*)g.A + (size_t)cur.pm * tstep; const char* cB = (const char*)g.Bt + (size_t)cur.pn * tstep;
    S.a_ready(cur);
    if constexpr (SP2) {
        PG8_STAGE(PG8_SB(0, 0), cB, voffB); PG8_STAGE(PG8_SB(0, 1), cB + hstep, voffB); PG8_STAGE(PG8_SA(0, 0), cA, voffA); PG8_STAGE(PG8_SA(0, 1), cA + hstep, voffA);
        if (wr == 1) PG8_BAR;
        PG8_WAIT_V(2); PG8_BAR;
        PG8_STAGE(PG8_SB(1, 0), cB + kstep, voffB); PG8_STAGE(PG8_SA(1, 0), cA + kstep, voffA); PG8_STAGE(PG8_SB(1, 1), cB + hstep + kstep, voffB);
        PG8_WAIT_V(6); PG8_BAR;
    } else {
        PG8_STAGE(PG8_SB(0, 0), cB, voffB); PG8_STAGE(PG8_SA(0, 0), cA, voffA); PG8_STAGE(PG8_SB(0, 1), cB + hstep, voffB); PG8_STAGE(PG8_SA(0, 1), cA + hstep, voffA);
        if (wr == 1) PG8_BAR;
        PG8_WAIT_V(4); PG8_BAR;
        PG8_STAGE(PG8_SB(1, 0), cB + kstep, voffB); PG8_STAGE(PG8_SA(1, 0), cA + kstep, voffA); PG8_STAGE(PG8_SB(1, 1), cB + hstep + kstep, voffB);
        PG8_WAIT_V(6); PG8_BAR;
    }
    for (;;) {
        const bool has_next = S.next(ui + 1, nxt);
        const char* nA = has_next ? (const char*)g.A + (size_t)nxt.pm * tstep : cA; const char* nB = has_next ? (const char*)g.Bt + (size_t)nxt.pn * tstep : cB;
        for (int t = 0; t < nt; t += 2) {
            const bool last = (t == nt - 2);
            const char* a1 = cA + (size_t)(t + 1) * kstep;
            const char* a2 = last ? nA : cA + (size_t)(t + 2) * kstep; const char* b2 = last ? nB : cB + (size_t)(t + 2) * kstep;
            const char* a3 = a2 + kstep; const char* b3 = b2 + kstep;
            if (last && has_next) S.a_ready(nxt);
            if constexpr (SP2) {
            PG8_LDB(B0, 0, 0); PG8_LDB(B1, 0, 1); PG8_SCHED; PG8_LDA(At, 0, 0); PG8_STAGE(PG8_SA(1, 1), a1 + hstep, voffA);
            PG8_WAIT_V(8); PG8_WAIT_L(0); PG8_BAR; PG8_MMA(0, 0, At, B0); PG8_MMA(0, 1, At, B1); PG8_BAR; PG8_SCHED;
            PG8_LDA(At, 0, 1); PG8_STAGE(PG8_SB(0, 0), b2, voffB); PG8_STAGE(PG8_SB(0, 1), b2 + hstep, voffB); PG8_STAGE(PG8_SA(0, 0), a2, voffA);
            PG8_WAIT_V(8); PG8_WAIT_L(0); PG8_BAR; PG8_MMA(1, 0, At, B0); PG8_MMA(1, 1, At, B1); PG8_BAR; PG8_SCHED;
            PG8_LDB(B0, 1, 0); PG8_LDB(B1, 1, 1); PG8_SCHED; PG8_LDA(At, 1, 0); PG8_STAGE(PG8_SA(0, 1), a2 + hstep, voffA);
            PG8_WAIT_V(8); PG8_WAIT_L(0); PG8_BAR; PG8_MMA(0, 0, At, B0); PG8_MMA(0, 1, At, B1); PG8_BAR; PG8_SCHED;
            PG8_LDA(At, 1, 1); PG8_STAGE(PG8_SB(1, 0), b3, voffB); PG8_STAGE(PG8_SB(1, 1), b3 + hstep, voffB); PG8_STAGE(PG8_SA(1, 0), a3, voffA);
            PG8_WAIT_V(8); PG8_WAIT_L(0); PG8_BAR; PG8_MMA(1, 0, At, B0); PG8_MMA(1, 1, At, B1); PG8_BAR; PG8_SCHED;
            } else {
            PG8_LDB(B0, 0, 0); PG8_SCHED; PG8_LDA(At, 0, 0); PG8_STAGE(PG8_SA(1, 1), a1 + hstep, voffA);
            PG8_WAIT_L(8); PG8_BAR; PG8_WAIT_L(0); PG8_MMA(0, 0, At, B0); PG8_BAR; PG8_SCHED;
            PG8_LDB(B1, 0, 1); PG8_STAGE(PG8_SB(0, 0), b2, voffB);
            PG8_BAR; PG8_WAIT_L(0); PG8_MMA(0, 1, At, B1); PG8_BAR;
            PG8_LDA(At, 0, 1); PG8_STAGE(PG8_SA(0, 0), a2, voffA);
            PG8_BAR; PG8_WAIT_L(0); PG8_MMA(1, 0, At, B0); PG8_BAR; PG8_SCHED;
            PG8_STAGE(PG8_SB(0, 1), b2 + hstep, voffB);
            PG8_WAIT_V(6); PG8_BAR; PG8_MMA(1, 1, At, B1); PG8_BAR;
            PG8_LDB(B0, 1, 0); PG8_SCHED; PG8_LDA(At, 1, 0); PG8_STAGE(PG8_SA(0, 1), a2 + hstep, voffA);
            PG8_WAIT_L(8); PG8_BAR; PG8_WAIT_L(0); PG8_MMA(0, 0, At, B0); PG8_BAR; PG8_SCHED;
            PG8_LDB(B1, 1, 1); PG8_STAGE(PG8_SB(1, 0), b3, voffB);
            PG8_BAR; PG8_WAIT_L(0); PG8_MMA(0, 1, At, B1); PG8_BAR;
            PG8_LDA(At, 1, 1); PG8_STAGE(PG8_SA(1, 0), a3, voffA);
            PG8_BAR; PG8_WAIT_L(0); PG8_MMA(1, 0, At, B0); PG8_BAR; PG8_SCHED;
            PG8_STAGE(PG8_SB(1, 1), b3 + hstep, voffB);
            PG8_WAIT_V(6); PG8_BAR; PG8_MMA(1, 1, At, B1); PG8_BAR;
            }
        }
        if constexpr (ALIGN_EPI) { if (wr == 0) PG8_BAR; }
        if constexpr (!Epi::AFTER_DRAIN) { E(acc, cur, wr, wc, fr, fq); S.done(cur); }
        if (!has_next) break;
#pragma unroll
        for (int a = 0; a < 2; ++a)
#pragma unroll
            for (int b = 0; b < 2; ++b)
#pragma unroll
                for (int m = 0; m < 4; ++m)
#pragma unroll
                    for (int n = 0; n < 2; ++n) acc[a][b][m][n] = (f32x4){0.f, 0.f, 0.f, 0.f};
        cur = nxt; cA = nA; cB = nB; ++ui;
        if constexpr (ALIGN_EPI) { if (wr == 1) PG8_BAR; }
    }
    PG8_WAIT_V(0);
    if constexpr (!ALIGN_EPI) { if (wr == 0) PG8_BAR; }
    PG8_BAR;
    if constexpr (Epi::AFTER_DRAIN) { E.fused(acc, cur, wr, wc, fr, fq, lds, wid, lane); S.done(cur); }
#undef PG8_SA
#undef PG8_SB
#undef PG8_STAGE
#undef PG8_LDA
#undef PG8_LDB
#undef PG8_MMA
#undef PG8_WAIT_V
#undef PG8_WAIT_L
#undef PG8_BAR
#undef PG8_SCHED
}

__device__ __forceinline__ float row_rstd(const float* ssp, int row, int fq) {
    const f32x4 p = *(const f32x4*)(ssp + (size_t)row * 16 + 4 * fq);
    float s = (p[0] + p[1]) + (p[2] + p[3]);
    s += __shfl_xor(s, 16); s += __shfl_xor(s, 32);
    return __builtin_amdgcn_rsqf(s * (1.0f / 1024.0f) + 1e-5f);
}
__device__ __forceinline__ u32x4 pack8(const float (&o)[8]) { u32x4 w; w.x = cvt_pk_bf16(o[0], o[1]); w.y = cvt_pk_bf16(o[2], o[3]); w.z = cvt_pk_bf16(o[4], o[5]); w.w = cvt_pk_bf16(o[6], o[7]); return w; }

struct EpiSwiGLU {
    static constexpr bool PERM = true, AFTER_DRAIN = false;
    bf16_t* G; const float* ssp;
    __device__ __forceinline__ void operator()(const f32x4 (&acc)[2][2][4][2], const Unit& u, int wr, int wc, int fr, int fq) const {
        const int row0 = u.pm * BM + wr * 64 + fr, col0 = u.pn * HALF + wc * 32 + 8 * fq;
#pragma unroll
        for (int ai = 0; ai < 2; ++ai)
#pragma unroll
            for (int m = 0; m < 4; ++m) {
                const int row = row0 + ai * HALF + m * 16; const float r = row_rstd(ssp, row, fq); float o[8];
#pragma unroll
                for (int n = 0; n < 2; ++n)
#pragma unroll
                    for (int e = 0; e < 4; ++e) { const float g = acc[ai][0][m][n][e] * r, up = acc[ai][1][m][n][e] * r;
                        o[4 * n + e] = g * __builtin_amdgcn_rcpf(1.0f + __builtin_amdgcn_exp2f(g * -1.4426950408889634f)) * up; }
                *(u32x4*)(G + (size_t)row * 2816 + col0) = pack8(o);
            }
    }
};
template <bool F32IN> struct EpiResid {
    static constexpr bool PERM = true, AFTER_DRAIN = false;
    const float* hin32; bf16_t* hb; float* ssp; float w;
    __device__ __forceinline__ void operator()(const f32x4 (&acc)[2][2][4][2], const Unit& u, int wr, int wc, int fr, int fq) const {
        const int row0 = u.pm * BM + wr * 64 + fr, col0 = u.pn * BM + wc * 32 + 8 * fq;
#pragma unroll
        for (int ai = 0; ai < 2; ++ai)
#pragma unroll
            for (int m = 0; m < 4; ++m) {
                const int row = row0 + ai * HALF + m * 16; float ss = 0.f;
#pragma unroll
                for (int bj = 0; bj < 2; ++bj) { const size_t off = (size_t)row * 1024 + col0 + bj * HALF;
                    f32x4 a0, a1;
                    if (F32IN) { a0 = *(const f32x4*)(hin32 + off); a1 = *(const f32x4*)(hin32 + off + 4); }
                    else { const u32x4 hv = *(const u32x4*)(hb + off);
                        a0 = (f32x4){__builtin_bit_cast(float, hv.x << 16), __builtin_bit_cast(float, hv.x & 0xffff0000u), __builtin_bit_cast(float, hv.y << 16), __builtin_bit_cast(float, hv.y & 0xffff0000u)};
                        a1 = (f32x4){__builtin_bit_cast(float, hv.z << 16), __builtin_bit_cast(float, hv.z & 0xffff0000u), __builtin_bit_cast(float, hv.w << 16), __builtin_bit_cast(float, hv.w & 0xffff0000u)}; }
                    const f32x4 v0 = a0 + acc[ai][bj][m][0] * w, v1 = a1 + acc[ai][bj][m][1] * w;
                    u32x4 pk; pk.x = cvt_pk_bf16(v0[0], v0[1]); pk.y = cvt_pk_bf16(v0[2], v0[3]); pk.z = cvt_pk_bf16(v1[0], v1[1]); pk.w = cvt_pk_bf16(v1[2], v1[3]);
                    *(u32x4*)(hb + off) = pk;
                    ss += (v0[0] * v0[0] + v0[1] * v0[1]) + (v0[2] * v0[2] + v0[3] * v0[3]) + (v1[0] * v1[0] + v1[1] * v1[1]) + (v1[2] * v1[2] + v1[3] * v1[3]); }
                ss += __shfl_xor(ss, 16); ss += __shfl_xor(ss, 32);
                if (fq == 0) ssp[(size_t)row * 16 + u.pn * 4 + wc] = ss;
                if (m & 1) asm volatile("" ::: "memory");
            }
    }
};
struct EpiMixIn {
    static constexpr bool PERM = true, AFTER_DRAIN = false;
    const float* ssp; const float* rope; bf16_t* Q; bf16_t* K; bf16_t* V; bf16_t* GB; bf16_t* Z;
    __device__ __forceinline__ void operator()(const f32x4 (&acc)[2][2][4][2], const Unit& u, int wr, int wc, int fr, int fq) const {
        const int row0 = u.pm * BM + wr * 64 + fr, pn = u.pn;
#pragma unroll
        for (int ai = 0; ai < 2; ++ai)
#pragma unroll
            for (int m = 0; m < 4; ++m) {
                const int row = row0 + ai * HALF + m * 16; const float r = row_rstd(ssp, row, fq);
                if (pn < 3) {
                    float t1[8], t2[8];
#pragma unroll
                    for (int n = 0; n < 2; ++n)
#pragma unroll
                        for (int e = 0; e < 4; ++e) { t1[4 * n + e] = acc[ai][0][m][n][e] * r; t2[4 * n + e] = acc[ai][1][m][n][e] * r; }
                    if (pn < 2 || wc < 2) {
                        const f32x4* rp = (const f32x4*)(rope + ((size_t)row * 32 + 8 * fq) * 2);
#pragma unroll
                        for (int i = 0; i < 4; ++i) { const f32x4 cs = rp[i];
                            { const float a = t1[2 * i], b = t2[2 * i]; t1[2 * i] = a * cs[0] - b * cs[1]; t2[2 * i] = b * cs[0] + a * cs[1]; }
                            { const float a = t1[2 * i + 1], b = t2[2 * i + 1]; t1[2 * i + 1] = a * cs[2] - b * cs[3]; t2[2 * i + 1] = b * cs[2] + a * cs[3]; } }
                    }
                    bf16_t* dst; float sc = 1.0f;
                    if (pn < 2) { dst = Q + (size_t)row * 512 + (4 * pn + wc) * 64 + 8 * fq; sc = 0.125f * 1.4426950408889634f; }
                    else if (wc < 2) dst = K + (size_t)row * 128 + wc * 64 + 8 * fq;
                    else dst = V + (size_t)row * 128 + (wc - 2) * 64 + 8 * fq;
#pragma unroll
                    for (int i = 0; i < 8; ++i) { t1[i] *= sc; t2[i] *= sc; }
                    *(u32x4*)dst = pack8(t1); *(u32x4*)(dst + 32) = pack8(t2);
                } else if (pn < 5) {
#pragma unroll
                    for (int bj = 0; bj < 2; ++bj) { float o[8];
#pragma unroll
                        for (int n = 0; n < 2; ++n)
#pragma unroll
                            for (int e = 0; e < 4; ++e) o[4 * n + e] = acc[ai][bj][m][n][e] * r;
                        *(u32x4*)(GB + (size_t)row * 512 + (pn - 3) * 256 + bj * HALF + wc * 32 + 8 * fq) = pack8(o); }
                } else {
                    float o[8];
#pragma unroll
                    for (int n = 0; n < 2; ++n)
#pragma unroll
                        for (int e = 0; e < 4; ++e) o[4 * n + e] = (acc[ai][0][m][n][e] * r) * (acc[ai][1][m][n][e] * r);
                    *(u32x4*)(Z + (size_t)row * 512 + (pn - 5) * HALF + wc * 32 + 8 * fq) = pack8(o);
                }
            }
    }
};
struct EpiScale {
    static constexpr bool PERM = true, AFTER_DRAIN = false;
    bf16_t* O; int ldo; const float* ssp; float scale;
    __device__ __forceinline__ void operator()(const f32x4 (&acc)[2][2][4][2], const Unit& u, int wr, int wc, int fr, int fq) const {
        const int row0 = u.pm * BM + wr * 64 + fr, col0 = u.pn * BM + wc * 32 + 8 * fq;
#pragma unroll
        for (int ai = 0; ai < 2; ++ai)
#pragma unroll
            for (int m = 0; m < 4; ++m) {
                const int row = row0 + ai * HALF + m * 16; const float r = row_rstd(ssp, row, fq) * scale;
#pragma unroll
                for (int bj = 0; bj < 2; ++bj) { float o[8];
#pragma unroll
                    for (int n = 0; n < 2; ++n)
#pragma unroll
                        for (int e = 0; e < 4; ++e) o[4 * n + e] = acc[ai][bj][m][n][e] * r;
                    *(u32x4*)(O + (size_t)row * ldo + col0 + bj * HALF) = pack8(o); }
            }
    }
};
struct ListOrder {
    int idx0, cnt, nN;
    __device__ bool next(int i, Unit& u) const { if (i >= cnt) return false; const int id = idx0 + i; u.pm = id / nN; u.pn = id % nN; return true; }
    __device__ __forceinline__ void a_ready(const Unit&) const {}
    __device__ __forceinline__ void done(const Unit&) const {}
};
}
namespace cg = cooperative_groups;
#define LAS __attribute__((address_space(3)))
#define GAS __attribute__((address_space(1)))
typedef unsigned v4u __attribute__((ext_vector_type(4)));
typedef unsigned v2u __attribute__((ext_vector_type(2)));
typedef float f32x4 __attribute__((ext_vector_type(4)));
typedef float f32x16 __attribute__((ext_vector_type(16)));
typedef short bf16x8 __attribute__((ext_vector_type(8)));
typedef short s16x4 __attribute__((ext_vector_type(4)));
#define LDS_WAIT() asm volatile("s_waitcnt lgkmcnt(0)" ::: "memory")
constexpr int NWAVES = 8, NTHR = 512;
constexpr int RING_BYTES = 131072, XTRA_OFF = RING_BYTES, LDS_BYTES = 147456;
constexpr int NPH = 12;

struct Args {
    const float* x; const float* mem; const int* pos; const float* g_ffn1; const float* w_ffn1_in; const float* w_ffn1_out; const float* g_mix; const float* w_mix_in;
    const float* sinks; const float* conv_w; const float* g_attn_out; const float* g_conv_out; const float* w_mix_out; const float* g_mem; const float* g_xattn;
    const float* w_xq; const float* w_xkv; const float* w_xo; const float* g_ffn2; const float* w_ffn2_in; const float* w_ffn2_out; const float* g_final;
    float* out; unsigned char* ws; int ph_lo, ph_hi;
};
__device__ __forceinline__ unsigned pk2(float lo, float hi) { return f2bf(lo) | (f2bf(hi) << 16); }
typedef float f32x2_t __attribute__((ext_vector_type(2))); typedef __bf16 bf16x2_t __attribute__((ext_vector_type(2)));
__device__ __forceinline__ unsigned cvtpk(float lo, float hi) { f32x2_t v = {lo, hi}; bf16x2_t b = __builtin_convertvector(v, bf16x2_t); return __builtin_bit_cast(unsigned, b); }
__device__ __forceinline__ float wave_sum(float v) {
#pragma unroll
    for (int o = 1; o < 64; o <<= 1) v += __shfl_xor(v, o);
    return v;
}
__device__ __forceinline__ int rowmap(int mode, int n0) {
    if (mode == 1) { const int bj = n0 >= DFF ? 1 : 0, jj = n0 - bj * DFF; return 256 * (jj >> 7) + 128 * bj + (jj & 127); }
    if (mode == 2) {
        if (n0 < 512) { const int hd = n0 >> 6, bj = (n0 >> 5) & 1; return 256 * (hd >> 2) + 128 * bj + 32 * (hd & 3); }
        if (n0 < 768) { const int c = n0 - 512, sl = c >> 6, bj = (c >> 5) & 1; return 512 + 128 * bj + 32 * sl; }
        if (n0 < 1280) return n0;
        const int c = n0 - 1280, bj = c >= 512 ? 1 : 0, cc = c - 512 * bj; return 1280 + 256 * (cc >> 7) + 128 * bj + (cc & 127);
    }
    return n0;
}
__device__ __forceinline__ void p0_transpose_item(const float* W, const float* gain, const float* gain2, int K, int N, bf16_t* WT, int mode, LAS float* scr, int item, int lane) {
    const int nblk = N / 32, kb = item / nblk, nb = item % nblk, k0 = 64 * kb, n0 = 32 * nb;
#pragma unroll 8
    for (int i = 0; i < 32; ++i) { const int kk = 2 * i + (lane >> 5), k = k0 + kk; float g = 1.0f; if (gain) g = (gain2 && k >= 512) ? gain2[k - 512] : gain[k];
        scr[kk * 33 + (lane & 31)] = W[(size_t)k * N + n0 + (lane & 31)] * g; }
    LDS_WAIT(); asm volatile("" ::: "memory");
    const int c = lane & 7, r0 = rowmap(mode, n0);
#pragma unroll
    for (int j = 0; j < 4; ++j) { const int n = (lane >> 3) + 8 * j; const LAS float* s = scr + (8 * c) * 33 + n;
        v4u o; o.x = pk2(s[0 * 33], s[1 * 33]); o.y = pk2(s[2 * 33], s[3 * 33]); o.z = pk2(s[4 * 33], s[5 * 33]); o.w = pk2(s[6 * 33], s[7 * 33]);
        *(v4u*)(WT + (size_t)(r0 + n) * K + k0 + 8 * c) = o; }
    LDS_WAIT(); asm volatile("" ::: "memory");
}
__device__ __forceinline__ void stats_row(const float* xrow, bf16_t* orow, float* ssrow, int lane) {
    const f32x4* xr = (const f32x4*)xrow + lane; f32x4 v[4]; float s = 0.f;
#pragma unroll
    for (int j = 0; j < 4; ++j) { v[j] = xr[64 * j]; s += (v[j].x * v[j].x + v[j].y * v[j].y) + (v[j].z * v[j].z + v[j].w * v[j].w); }
    s = wave_sum(s);
    v2u* o8 = (v2u*)orow + lane;
#pragma unroll
    for (int j = 0; j < 4; ++j) { v2u w; w.x = cvtpk(v[j].x, v[j].y); w.y = cvtpk(v[j].z, v[j].w); o8[64 * j] = w; }
    if (lane < 16) ssrow[lane] = lane == 0 ? s : 0.f;
}
__device__ __forceinline__ void phase_prep(const Args& a, LAS unsigned char* lds, int G, int vcu) {
    const int tid = threadIdx.x, lane = tid & 63, wave = __builtin_amdgcn_readfirstlane(tid >> 6);
    LAS float* scr = (LAS float*)(lds + wave * 16384);
    const int gw = vcu * NWAVES + wave, NGW = G * NWAVES;
    unsigned char* ws = a.ws;
    constexpr int I_FI = (DM / 64) * (2 * DFF / 32), I_FO = (DFF / 64) * (DM / 32), I_MI = (DM / 64) * (INC / 32), I_SQ = (DM / 64) * (DM / 32), I_KV = (DM / 64) * (2 * DM / 32);
    constexpr int NITEMS = 2 * I_FI + 2 * I_FO + I_MI + 3 * I_SQ + I_KV;
    for (int it = gw; it < NITEMS; it += NGW) {
        int r = it;
        if (r < I_FI) { p0_transpose_item(a.w_ffn1_in, a.g_ffn1, nullptr, DM, 2 * DFF, (bf16_t*)(ws + WS_W1I), 1, scr, r, lane); continue; } r -= I_FI;
        if (r < I_FI) { p0_transpose_item(a.w_ffn2_in, a.g_ffn2, nullptr, DM, 2 * DFF, (bf16_t*)(ws + WS_W2I), 1, scr, r, lane); continue; } r -= I_FI;
        if (r < I_FO) { p0_transpose_item(a.w_ffn1_out, nullptr, nullptr, DFF, DM, (bf16_t*)(ws + WS_W1O), 0, scr, r, lane); continue; } r -= I_FO;
        if (r < I_FO) { p0_transpose_item(a.w_ffn2_out, nullptr, nullptr, DFF, DM, (bf16_t*)(ws + WS_W2O), 0, scr, r, lane); continue; } r -= I_FO;
        if (r < I_MI) { p0_transpose_item(a.w_mix_in, a.g_mix, nullptr, DM, INC, (bf16_t*)(ws + WS_WMI), 2, scr, r, lane); continue; } r -= I_MI;
        if (r < I_SQ) { p0_transpose_item(a.w_mix_out, a.g_attn_out, a.g_conv_out, DM, DM, (bf16_t*)(ws + WS_WMO), 0, scr, r, lane); continue; } r -= I_SQ;
        if (r < I_SQ) { p0_transpose_item(a.w_xq, a.g_xattn, nullptr, DM, DM, (bf16_t*)(ws + WS_WXQ), 0, scr, r, lane); continue; } r -= I_SQ;
        if (r < I_SQ) { p0_transpose_item(a.w_xo, nullptr, nullptr, DM, DM, (bf16_t*)(ws + WS_WXO), 0, scr, r, lane); continue; } r -= I_SQ;
        p0_transpose_item(a.w_xkv, a.g_mem, nullptr, DM, 2 * DM, (bf16_t*)(ws + WS_WXKV), 0, scr, r, lane);
    }
    for (int m = gw; m < T + MROWS; m += NGW) {
        if (m < T) stats_row(a.x + (size_t)m * DM, (bf16_t*)(ws + WS_HB) + (size_t)m * DM, (float*)(ws + ws_ss(0)) + (size_t)m * 16, lane);
        else { const int r = m - T; stats_row(a.mem + (size_t)r * DM, (bf16_t*)(ws + WS_MEMB) + (size_t)r * DM, (float*)(ws + WS_SSMEM) + (size_t)r * 16, lane); }
    }
    float* rope = (float*)(ws + WS_ROPE);
    for (int i = (vcu * NTHR + tid); i < T * 32; i += G * NTHR) {
        const int row = i >> 5, d = i & 31;
        const double invf = exp2(-(double)d * (13.287712379549449 / 32.0));
        const double ang = (double)a.pos[row] * invf;
        const double kq = rint(ang * 0.15915494309189535); const double y = fma(-kq, 6.283185307179586, ang) - kq * 2.4492935982947064e-16;
        const float yf = (float)y;
        *(float2*)(rope + (size_t)i * 2) = make_float2(cosf(yf), sinf(yf));
    }
}
__device__ __forceinline__ int crow(int r, int hi) { return (r & 3) + 8 * (r >> 2) + 4 * hi; }
__device__ __forceinline__ s16x4 vtr(const LAS unsigned char* p) { typedef short v4i16_t __attribute__((ext_vector_type(4))); return __builtin_bit_cast(s16x4, __builtin_amdgcn_ds_read_tr16_b64_v4i16((LAS v4i16_t*)p)); }
#define MFMA32(A, B, C) __builtin_amdgcn_mfma_f32_32x32x16_bf16((A), (B), (C), 0, 0, 0)
__device__ __forceinline__ f32x16 mfma32z(bf16x8 a, bf16x8 b) { f32x16 r = __builtin_amdgcn_mfma_f32_32x32x16_bf16(a, b, f32x16{}, 0, 0, 0); asm volatile("" : "+v"(r) : "v"(a), "v"(b)); return r; }
__device__ __forceinline__ void phase_swa(const Args& a, LAS unsigned char* lds, int G, int vcu) {
    const int tid = threadIdx.x, lane = tid & 63, r32 = lane & 31, hi = lane >> 5, wid = __builtin_amdgcn_readfirstlane(tid >> 6);
    unsigned char* ws = a.ws;
    const bf16_t* Q = (const bf16_t*)(ws + WS_Q); const bf16_t* Kg = (const bf16_t*)(ws + WS_K); const bf16_t* Vg = (const bf16_t*)(ws + WS_V);
    const bf16_t* GB = (const bf16_t*)(ws + WS_GB); const bf16_t* Z = (const bf16_t*)(ws + WS_Z); bf16_t* MX = (bf16_t*)(ws + WS_MIXED);
    LAS float* SSX = (LAS float*)(lds + XTRA_OFF);
    const float sink2 = a.sinks[wid] * LOG2E;
    const int kvh = wid >> 2;
    for (int unit = vcu; unit < NB * (SEQ / BLK); unit += G) {
        const int b = unit / (SEQ / BLK), blk = unit % (SEQ / BLK); const size_t t0 = (size_t)b * SEQ + (size_t)blk * BLK;
#pragma unroll
        for (int kh = 0; kh < 2; ++kh)
#pragma unroll
            for (int kt = 0; kt < 4; ++kt) {
                v4u kv = (v4u){0u, 0u, 0u, 0u}, vv = (v4u){0u, 0u, 0u, 0u};
                if (blk > 0 || kt >= 2) {
                    const size_t kr = t0 - 128 + 64 * kt;
                    kv = *(const v4u*)(Kg + (kr + lane) * KVW + kh * 64 + wid * 8);
                    vv = *(const v4u*)(Vg + (kr + 16 * (wid & 3) + (lane >> 2)) * KVW + kh * 64 + (wid >> 2) * 32 + (lane & 3) * 8);
                }
                *(LAS v4u*)(lds + (kh * 4 + kt) * 8192 + wid * 1024 + lane * 16) = kv;
                *(LAS v4u*)(lds + 65536 + (kh * 4 + kt) * 8192 + wid * 1024 + lane * 16) = vv;
            }
        __syncthreads();
#pragma unroll
        for (int half = 0; half < 2; ++half) {
        v2u opk[2][2][4];
#pragma unroll
        for (int q2 = 0; q2 < 2; ++q2) { const int qs = 2 * half + q2;
            const bf16_t* Qw = Q + (t0 + 32 * qs + r32) * AW + wid * 64;
            bf16x8 qr[4];
#pragma unroll
            for (int d0 = 0; d0 < 4; ++d0) qr[d0] = *(const bf16x8*)(Qw + d0 * 16 + hi * 8);
            const int T0 = qs >> 1;
            f32x16 p[3][2];
#pragma unroll
            for (int i = 0; i < 3; ++i) {
                const LAS unsigned char* kb = lds + (kvh * 4 + T0 + i) * 8192 + hi * 1024 + r32 * 16;
#pragma unroll
                for (int d0 = 0; d0 < 4; ++d0) {
                    const bf16x8 b0 = *(const LAS bf16x8*)(kb + d0 * 2048), b1 = *(const LAS bf16x8*)(kb + d0 * 2048 + 512);
                    if (d0 == 0) { p[i][0] = mfma32z(b0, qr[0]); p[i][1] = mfma32z(b1, qr[0]); }
                    else { p[i][0] = MFMA32(b0, qr[d0], p[i][0]); p[i][1] = MFMA32(b1, qr[d0], p[i][1]); }
                }
            }
            const int qi = 32 * qs + r32; float mx = sink2;
#pragma unroll
            for (int i = 0; i < 3; ++i)
#pragma unroll
                for (int h2 = 0; h2 < 2; ++h2)
#pragma unroll
                    for (int r = 0; r < 16; ++r) { const int ki = 64 * (T0 + i) + 32 * h2 + crow(r, hi);
                        const bool ok = (ki > qi) && (ki <= qi + 128) && (blk > 0 || ki >= 128);
                        const float s = ok ? p[i][h2][r] : -1e30f; p[i][h2][r] = s; mx = fmaxf(mx, s); }
            mx = fmaxf(mx, __shfl_xor(mx, 32));
            float l = 0.f;
#pragma unroll
            for (int i = 0; i < 3; ++i)
#pragma unroll
                for (int h2 = 0; h2 < 2; ++h2)
#pragma unroll
                    for (int r = 0; r < 16; ++r) { const float e = __builtin_amdgcn_exp2f(p[i][h2][r] - mx); p[i][h2][r] = e; l += e; }
            l += __shfl_xor(l, 32); l += __builtin_amdgcn_exp2f(sink2 - mx);
            const float rl = 1.0f / l;
            f32x16 oT[2];
#pragma unroll
            for (int i = 0; i < 3; ++i) {
                const LAS unsigned char* vp = lds + 65536 + (kvh * 4 + T0 + i) * 8192 + ((lane >> 4) & 1) * 32 + (lane & 3) * 8 + (4 * hi + ((lane & 15) >> 2)) * 64;
#pragma unroll
                for (int ks = 0; ks < 4; ++ks) {
                    const f32x16& ps = p[i][ks >> 1]; const int rb = (ks & 1) * 8;
                    v4u pw; pw.x = cvtpk(ps[rb + 0], ps[rb + 1]); pw.y = cvtpk(ps[rb + 2], ps[rb + 3]); pw.z = cvtpk(ps[rb + 4], ps[rb + 5]); pw.w = cvtpk(ps[rb + 6], ps[rb + 7]);
                    const bf16x8 pf = __builtin_bit_cast(bf16x8, pw);
#pragma unroll
                    for (int d0 = 0; d0 < 2; ++d0) {
                        const s16x4 lo = vtr(vp + d0 * 4096 + ks * 1024), hh = vtr(vp + d0 * 4096 + ks * 1024 + 512);
                        const bf16x8 vf = (bf16x8){lo[0], lo[1], lo[2], lo[3], hh[0], hh[1], hh[2], hh[3]};
                        if (i == 0 && ks == 0) oT[d0] = mfma32z(vf, pf); else oT[d0] = MFMA32(vf, pf, oT[d0]);
                    }
                }
            }
            float ss = 0.f;
#pragma unroll
            for (int d0 = 0; d0 < 2; ++d0)
#pragma unroll
                for (int r = 0; r < 16; ++r) { const float o = oT[d0][r] * rl; oT[d0][r] = o; ss += o * o; }
            ss += __shfl_xor(ss, 32);
            if (hi == 0) SSX[(32 * qs + r32) * 8 + wid] = ss;
#pragma unroll
            for (int d0 = 0; d0 < 2; ++d0)
#pragma unroll
                for (int g = 0; g < 4; ++g) { v2u w; w.x = cvtpk(oT[d0][4 * g], oT[d0][4 * g + 1]); w.y = cvtpk(oT[d0][4 * g + 2], oT[d0][4 * g + 3]); opk[q2][d0][g] = w; }
        }
        __syncthreads();
#pragma unroll
        for (int q2 = 0; q2 < 2; ++q2) { const int qs = 2 * half + q2;
            const f32x4 s0 = *(const LAS f32x4*)(SSX + (32 * qs + r32) * 8), s1 = *(const LAS f32x4*)(SSX + (32 * qs + r32) * 8 + 4);
            const float tot = ((s0[0] + s0[1]) + (s0[2] + s0[3])) + ((s1[0] + s1[1]) + (s1[2] + s1[3]));
            const float ra = __builtin_amdgcn_rsqf(tot * (1.0f / AW) + RMS_EPS);
            bf16_t* dst = MX + (t0 + 32 * qs + r32) * DM + wid * 64 + 4 * hi;
#pragma unroll
            for (int d0 = 0; d0 < 2; ++d0)
#pragma unroll
                for (int g = 0; g < 4; ++g) { const v2u w = opk[q2][d0][g]; v2u o;
                    o.x = cvtpk(bf2f(w.x) * ra, bf2f(w.x >> 16) * ra); o.y = cvtpk(bf2f(w.y) * ra, bf2f(w.y >> 16) * ra);
                    *(v2u*)(dst + 32 * d0 + 8 * g) = o; }
        }
        }
        {
            const int c0 = 8 * lane; float cw[3][8];
#pragma unroll
            for (int j = 0; j < 3; ++j) { const f32x4 w0 = *(const f32x4*)(a.conv_w + j * CW + c0), w1 = *(const f32x4*)(a.conv_w + j * CW + c0 + 4);
                cw[j][0] = w0[0]; cw[j][1] = w0[1]; cw[j][2] = w0[2]; cw[j][3] = w0[3]; cw[j][4] = w1[0]; cw[j][5] = w1[1]; cw[j][6] = w1[2]; cw[j][7] = w1[3]; }
            const size_t tw = t0 + 16 * wid; const int s0 = blk * BLK + 16 * wid;
            v4u z2 = (v4u){0u, 0u, 0u, 0u}, z1 = (v4u){0u, 0u, 0u, 0u};
            if (s0 >= 2) z2 = *(const v4u*)(Z + (tw - 2) * CW + c0);
            if (s0 >= 1) z1 = *(const v4u*)(Z + (tw - 1) * CW + c0);
            for (int tt = 0; tt < 16; ++tt) {
                const v4u z0 = *(const v4u*)(Z + (tw + tt) * CW + c0), gb = *(const v4u*)(GB + (tw + tt) * CW + c0);
                float y[8]; float ss = 0.f;
#pragma unroll
                for (int e = 0; e < 4; ++e) {
                    const unsigned a2 = z2[e], a1 = z1[e], a0 = z0[e], gg = gb[e];
                    const float ylo = (cw[0][2 * e] * bf2f(a2) + cw[1][2 * e] * bf2f(a1) + cw[2][2 * e] * bf2f(a0)) * bf2f(gg);
                    const float yhi = (cw[0][2 * e + 1] * bf2f(a2 >> 16) + cw[1][2 * e + 1] * bf2f(a1 >> 16) + cw[2][2 * e + 1] * bf2f(a0 >> 16)) * bf2f(gg >> 16);
                    y[2 * e] = ylo; y[2 * e + 1] = yhi; ss += ylo * ylo + yhi * yhi;
                }
                ss = wave_sum(ss); const float rc = __builtin_amdgcn_rsqf(ss * (1.0f / CW) + RMS_EPS);
                v4u o; o.x = cvtpk(y[0] * rc, y[1] * rc); o.y = cvtpk(y[2] * rc, y[3] * rc); o.z = cvtpk(y[4] * rc, y[5] * rc); o.w = cvtpk(y[6] * rc, y[7] * rc);
                *(v4u*)(MX + (tw + tt) * DM + AW + c0) = o;
                z2 = z1; z1 = z0;
            }
        }
        __syncthreads();
    }
}
__device__ __forceinline__ void phase_xattn(const Args& a, LAS unsigned char* lds, int G, int vcu) {
    const int tid0 = threadIdx.x, wid = __builtin_amdgcn_readfirstlane(tid0 >> 6);
    unsigned char* ws = a.ws;
    const bf16_t* XQ = (const bf16_t*)(ws + WS_XQ); const bf16_t* KVM = (const bf16_t*)(ws + WS_KVM); bf16_t* XO = (bf16_t*)(ws + WS_XO);
    for (int unit = vcu; unit < (T / 256) * XH; unit += G) {
        int tid = tid0; asm volatile("" : "+v"(tid));
        const int lane = tid & 63, r32 = lane & 31, hi = lane >> 5;
        const int pm = unit / XH, h = unit % XH; const size_t t0 = (size_t)pm * 256; const int b = (int)(t0 / SEQ);
        const bf16_t* Kh = KVM + (size_t)(b * MEML) * 2 * DM + h * XHD; const bf16_t* Vh = Kh + DM;
        {   const int mq = tid >> 5, c = tid & 31;
            const unsigned loff = (unsigned)(mq * (2 * DM * 2) + c * 16);
            LAS unsigned char* d0p = lds + mq * 512 + ((c ^ mq) << 4); LAS unsigned char* d1p = lds + mq * 512 + (((c ^ mq) ^ 16) << 4);
#pragma unroll
            for (int i = 0; i < 16; ++i) { GAS const char* bp = (GAS const char*)Kh + (size_t)i * (16 * 2 * DM * 2); asm("" : "+s"(bp)); const v4u v = *(GAS const v4u*)(bp + loff); *(LAS v4u*)(((i & 1) ? d1p : d0p) + i * 8192) = v; } }
        const bf16_t* Qw = XQ + (t0 + 32 * wid + r32) * DM + h * XHD + hi * 8;
        __syncthreads();
        v4u pw[16]; float l = 0.f, m_run = -1e30f, f0 = 1.0f;
#pragma unroll
        for (int ps = 0; ps < 2; ++ps) {
            __builtin_amdgcn_sched_barrier(0);
            bf16x8 qc[4], qn[4];
#pragma unroll
            for (int dd = 0; dd < 4; ++dd) qc[dd] = *(const bf16x8*)(Qw + dd * 16);
            f32x16 p[4];
#pragma unroll
            for (int g = 0; g < 4; ++g) {
                if (g < 3) {
#pragma unroll
                    for (int dd = 0; dd < 4; ++dd) qn[dd] = *(const bf16x8*)(Qw + (4 * g + 4 + dd) * 16);
                }
#pragma unroll
                for (int dd = 0; dd < 4; ++dd) {
                    const int d0 = 4 * g + dd; unsigned ab = (unsigned)(ps * 65536 + r32 * 512 + (((2 * d0 + hi) ^ r32) << 4));
                    asm volatile("" : "+v"(ab));
#pragma unroll
                    for (int j = 0; j < 4; ++j) { const bf16x8 kf = *(const LAS bf16x8*)(lds + ab + j * 16384); if (d0 == 0) p[j] = mfma32z(kf, qc[0]); else p[j] = MFMA32(kf, qc[dd], p[j]); }
                }
                __builtin_amdgcn_sched_barrier(0);
#pragma unroll
                for (int dd = 0; dd < 4; ++dd) qc[dd] = qn[dd];
            }
            __builtin_amdgcn_sched_barrier(0);
            float mx = -1e30f;
#pragma unroll
            for (int j = 0; j < 4; ++j)
#pragma unroll
                for (int r = 0; r < 16; ++r) mx = fmaxf(mx, p[j][r]);
            mx = fmaxf(mx, __shfl_xor(mx, 32));
            const float mnew = fmaxf(m_run, mx);
            if (ps == 1) { f0 = __builtin_amdgcn_exp2f(m_run - mnew); l *= f0; }
            m_run = mnew;
            float ls = 0.f;
#pragma unroll
            for (int j = 0; j < 4; ++j) {
#pragma unroll
                for (int r = 0; r < 16; ++r) { const float e = __builtin_amdgcn_exp2f(p[j][r] - mnew); p[j][r] = e; ls += e; }
                v4u w0, w1;
                w0.x = cvtpk(p[j][0], p[j][1]); w0.y = cvtpk(p[j][2], p[j][3]); w0.z = cvtpk(p[j][4], p[j][5]); w0.w = cvtpk(p[j][6], p[j][7]);
                w1.x = cvtpk(p[j][8], p[j][9]); w1.y = cvtpk(p[j][10], p[j][11]); w1.z = cvtpk(p[j][12], p[j][13]); w1.w = cvtpk(p[j][14], p[j][15]);
                pw[8 * ps + 2 * j] = w0; pw[8 * ps + 2 * j + 1] = w1;
                __builtin_amdgcn_sched_barrier(0);
            }
            l += ls;
            __builtin_amdgcn_sched_barrier(0);
        }
        l += __shfl_xor(l, 32); const float rl = 1.0f / l;
        __syncthreads();
        {   const int mq = tid >> 5, c = tid & 31;
            const unsigned loff = (unsigned)(mq * (2 * DM * 2) + c * 16); LAS unsigned char* dp = lds + (c >> 2) * 16384 + mq * 64 + (c & 3) * 16;
#pragma unroll
            for (int i = 0; i < 16; ++i) { GAS const char* bp = (GAS const char*)Vh + (size_t)i * (16 * 2 * DM * 2); asm("" : "+s"(bp)); const v4u v = *(GAS const v4u*)(bp + loff); *(LAS v4u*)(dp + i * 1024) = v; } }
        __syncthreads();
        const LAS unsigned char* vp = lds + ((lane >> 4) & 1) * 32 + (lane & 3) * 8 + (4 * hi + ((lane & 15) >> 2)) * 64;
        bf16_t* dst = XO + (t0 + 32 * wid + r32) * DM + h * XHD + 4 * hi;
#pragma unroll
        for (int db = 0; db < 8; ++db) {
            f32x16 o;
            unsigned vb = (unsigned)(db * 16384); asm volatile("" : "+v"(vb));
#pragma unroll
            for (int ks = 0; ks < 16; ++ks) {
                const s16x4 lo = vtr(vp + vb + ks * 1024), hh = vtr(vp + vb + ks * 1024 + 512);
                const bf16x8 vf = (bf16x8){lo[0], lo[1], lo[2], lo[3], hh[0], hh[1], hh[2], hh[3]};
                if (ks == 0) o = mfma32z(vf, __builtin_bit_cast(bf16x8, pw[0])); else o = MFMA32(vf, __builtin_bit_cast(bf16x8, pw[ks]), o);
                if (ks == 7) {
#pragma unroll
                    for (int r = 0; r < 16; ++r) o[r] *= f0;
                }
            }
#pragma unroll
            for (int g = 0; g < 4; ++g) { v2u w; w.x = cvtpk(o[4 * g] * rl, o[4 * g + 1] * rl); w.y = cvtpk(o[4 * g + 2] * rl, o[4 * g + 3] * rl); *(v2u*)(dst + 32 * db + 8 * g) = w; }
        }
        __syncthreads();
    }
}
__device__ __forceinline__ void phase_final(const Args& a, int G, int vcu) {
    const int tid = threadIdx.x, lane = tid & 63, wave = tid >> 6;
    const float* ssp = (const float*)(a.ws + ws_ss(4)); const bf16_t* HB = (const bf16_t*)(a.ws + WS_HB);
    f32x4 gv[4];
#pragma unroll
    for (int j = 0; j < 2; ++j) { gv[2 * j] = *(const f32x4*)(a.g_final + 512 * j + 8 * lane); gv[2 * j + 1] = *(const f32x4*)(a.g_final + 512 * j + 8 * lane + 4); }
    for (int m = vcu * NWAVES + wave; m < T; m += G * NWAVES) {
        const f32x4 p0 = *(const f32x4*)(ssp + (size_t)m * 16), p1 = *(const f32x4*)(ssp + (size_t)m * 16 + 4), p2 = *(const f32x4*)(ssp + (size_t)m * 16 + 8), p3 = *(const f32x4*)(ssp + (size_t)m * 16 + 12);
        const float s = (((p0[0] + p0[1]) + (p0[2] + p0[3])) + ((p1[0] + p1[1]) + (p1[2] + p1[3]))) + (((p2[0] + p2[1]) + (p2[2] + p2[3])) + ((p3[0] + p3[1]) + (p3[2] + p3[3])));
        const float r = 1.0f / sqrtf(s * (1.0f / DM) + RMS_EPS);
#pragma unroll
        for (int j = 0; j < 2; ++j) { const v4u hv = *(const v4u*)(HB + (size_t)m * DM + 512 * j + 8 * lane);
            f32x4 o0 = (f32x4){bf2f(hv.x), bf2f(hv.x >> 16), bf2f(hv.y), bf2f(hv.y >> 16)}, o1 = (f32x4){bf2f(hv.z), bf2f(hv.z >> 16), bf2f(hv.w), bf2f(hv.w >> 16)};
            o0 = o0 * r * gv[2 * j]; o1 = o1 * r * gv[2 * j + 1];
            float* op = a.out + (size_t)m * DM + 512 * j + 8 * lane; *(f32x4*)op = o0; *(f32x4*)(op + 4) = o1; }
    }
}
#define GEMM_PHASE(EPI, SCHED, g, S, E) pg8::gemm_phase<EPI, SCHED, true, true>(lds, g, S, E)
__device__ __forceinline__ void ph_ffn_in(LAS unsigned char* lds, unsigned char* ws, int G, int bx, size_t wofs, int ssi) {
    pg8::Gemm g{(const bf16_t*)(ws + WS_HB), (const bf16_t*)(ws + wofs), T, 2 * DFF, DM}; pg8::StaticOrder S; S.init(T, 2 * DFF, G, bx);
    pg8::EpiSwiGLU E{(bf16_t*)(ws + WS_G), (const float*)(ws + ws_ss(ssi))};
    GEMM_PHASE(pg8::EpiSwiGLU, pg8::StaticOrder, g, S, E);
}
template <bool F32IN> __device__ __forceinline__ void ph_resid(LAS unsigned char* lds, unsigned char* ws, int G, int bx, size_t aofs, size_t wofs, int K, const float* hin32, int sso, float w) {
    pg8::Gemm g{(const bf16_t*)(ws + aofs), (const bf16_t*)(ws + wofs), T, DM, K}; pg8::StaticOrder S; S.init(T, DM, G, bx);
    pg8::EpiResid<F32IN> E{hin32, (bf16_t*)(ws + WS_HB), (float*)(ws + ws_ss(sso)), w};
    GEMM_PHASE(pg8::EpiResid<F32IN>, pg8::StaticOrder, g, S, E);
}
__device__ __forceinline__ void ph_mix_in(LAS unsigned char* lds, unsigned char* ws, int G, int bx) {
    { pg8::Gemm g{(const bf16_t*)(ws + WS_HB), (const bf16_t*)(ws + WS_WMI), T, INC, DM}; pg8::StaticOrder S; S.init(T, INC, G, bx);
      pg8::EpiMixIn E{(const float*)(ws + ws_ss(1)), (const float*)(ws + WS_ROPE), (bf16_t*)(ws + WS_Q), (bf16_t*)(ws + WS_K), (bf16_t*)(ws + WS_V), (bf16_t*)(ws + WS_GB), (bf16_t*)(ws + WS_Z)};
      GEMM_PHASE(pg8::EpiMixIn, pg8::StaticOrder, g, S, E); }
    { int idx0, cnt;
      if (G == 256) { idx0 = bx - 128; cnt = (bx >= 128 && bx < 160) ? 1 : 0; }
      else { const int per = (32 + G - 1) / G; idx0 = bx * per; cnt = idx0 >= 32 ? 0 : (idx0 + per <= 32 ? per : 32 - idx0); }
      pg8::ListOrder S{idx0, cnt, 8};
      pg8::Gemm g{(const bf16_t*)(ws + WS_MEMB), (const bf16_t*)(ws + WS_WXKV), MROWS, 2 * DM, DM};
      pg8::EpiScale E{(bf16_t*)(ws + WS_KVM), 2 * DM, (const float*)(ws + WS_SSMEM), 1.0f};
      GEMM_PHASE(pg8::EpiScale, pg8::ListOrder, g, S, E); }
}
__device__ __forceinline__ void ph_xq(LAS unsigned char* lds, unsigned char* ws, int G, int bx) {
    pg8::Gemm g{(const bf16_t*)(ws + WS_HB), (const bf16_t*)(ws + WS_WXQ), T, DM, DM}; pg8::StaticOrder S; S.init(T, DM, G, bx);
    pg8::EpiScale E{(bf16_t*)(ws + WS_XQ), DM, (const float*)(ws + ws_ss(2)), XSCALE};
    GEMM_PHASE(pg8::EpiScale, pg8::StaticOrder, g, S, E);
}
#ifndef PHMASK
#define PHMASK 0xFFF
#endif
#ifndef REPEAT_PH
#define REPEAT_PH -1
#endif
__global__ void __launch_bounds__(NTHR, 2) mk_fwd(Args a) {
    extern __shared__ __attribute__((aligned(16))) unsigned char lds_raw[];
    LAS unsigned char* lds = (LAS unsigned char*)lds_raw;
    const int G = gridDim.x, bx = blockIdx.x, vcu = (G % 8 == 0) ? (bx % 8) * (G / 8) + bx / 8 : bx;
    unsigned char* ws = a.ws;
    const int lo = a.ph_lo, hi = a.ph_hi;
#define IN(k) (((PHMASK >> (k)) & 1) && lo <= (k) && (k) < hi)
#define SEAM(k) do { if (IN(k) && IN((k) + 1)) cg::this_grid().sync(); } while (0)
#define RUN(k, CALL) do { if (IN(k)) { CALL; if (REPEAT_PH == (k)) { cg::this_grid().sync(); CALL; } } } while (0)
    RUN(0, phase_prep(a, lds, G, vcu));
    SEAM(0);
    RUN(1, ph_ffn_in(lds, ws, G, bx, WS_W1I, 0));
    SEAM(1);
    RUN(2, ph_resid<true>(lds, ws, G, bx, WS_G, WS_W1O, DFF, a.x, 1, 0.5f));
    SEAM(2);
    RUN(3, ph_mix_in(lds, ws, G, bx));
    SEAM(3);
    RUN(4, phase_swa(a, lds, G, vcu));
    SEAM(4);
    RUN(5, ph_resid<false>(lds, ws, G, bx, WS_MIXED, WS_WMO, DM, nullptr, 2, 1.0f));
    SEAM(5);
    RUN(6, ph_xq(lds, ws, G, bx));
    SEAM(6);
    RUN(7, phase_xattn(a, lds, G, vcu));
    SEAM(7);
    RUN(8, ph_resid<false>(lds, ws, G, bx, WS_XO, WS_WXO, DM, nullptr, 3, 1.0f));
    SEAM(8);
    RUN(9, ph_ffn_in(lds, ws, G, bx, WS_W2I, 3));
    SEAM(9);
    RUN(10, ph_resid<false>(lds, ws, G, bx, WS_G, WS_W2O, DFF, nullptr, 4, 0.5f));
    SEAM(10);
    RUN(11, phase_final(a, G, vcu));
#undef IN
#undef SEAM
#undef RUN
}
static void fill_args(Args& a, void* const* d_in, void* d_out, void* d_ws) {
    a.x = (const float*)d_in[0]; a.mem = (const float*)d_in[1]; a.pos = (const int*)d_in[2]; a.g_ffn1 = (const float*)d_in[3]; a.w_ffn1_in = (const float*)d_in[4]; a.w_ffn1_out = (const float*)d_in[5];
    a.g_mix = (const float*)d_in[6]; a.w_mix_in = (const float*)d_in[7]; a.sinks = (const float*)d_in[8]; a.conv_w = (const float*)d_in[9]; a.g_attn_out = (const float*)d_in[10]; a.g_conv_out = (const float*)d_in[11];
    a.w_mix_out = (const float*)d_in[12]; a.g_mem = (const float*)d_in[13]; a.g_xattn = (const float*)d_in[14]; a.w_xq = (const float*)d_in[15]; a.w_xkv = (const float*)d_in[16]; a.w_xo = (const float*)d_in[17];
    a.g_ffn2 = (const float*)d_in[18]; a.w_ffn2_in = (const float*)d_in[19]; a.w_ffn2_out = (const float*)d_in[20]; a.g_final = (const float*)d_in[21];
    a.out = (float*)d_out; a.ws = (unsigned char*)d_ws;
}
extern "C" void kernel_launch(void* const* d_in, const int* in_sizes, int n_in, void* d_out, int out_size, void* d_ws, size_t ws_size, hipStream_t stream) {
    if (n_in != 22 || out_size != T * DM || ws_size < WS_END) { fprintf(stderr, "kernel_launch: unexpected shapes (n_in %d out %d ws %zu)\n", n_in, out_size, ws_size); return; }
    static int grid = 0;
    if (grid == 0) {
        int dev = 0, cus = 0, per_cu = 0;
        if (hipFuncSetAttribute((const void*)mk_fwd, hipFuncAttributeMaxDynamicSharedMemorySize, LDS_BYTES) != hipSuccess) { fprintf(stderr, "kernel_launch: hipFuncSetAttribute failed\n"); grid = -1; return; }
        if (hipGetDevice(&dev) != hipSuccess || hipDeviceGetAttribute(&cus, hipDeviceAttributeMultiprocessorCount, dev) != hipSuccess) { fprintf(stderr, "kernel_launch: device query failed\n"); grid = -1; return; }
        if (hipOccupancyMaxActiveBlocksPerMultiprocessor(&per_cu, (const void*)mk_fwd, NTHR, LDS_BYTES) != hipSuccess || per_cu < 1) { fprintf(stderr, "kernel_launch: occupancy query says %d blocks per CU\n", per_cu); grid = -1; return; }
        grid = cus;
    }
    if (grid < 0) return;
    Args a{}; fill_args(a, d_in, d_out, d_ws); a.ph_lo = 0; a.ph_hi = NPH;
    void* args[] = {&a};
    const hipError_t e = hipLaunchCooperativeKernel((const void*)mk_fwd, dim3(grid), dim3(NTHR), args, LDS_BYTES, stream);
    if (e != hipSuccess) fprintf(stderr, "kernel_launch: cooperative launch failed: %s (grid %d)\n", hipGetErrorString(e), grid);
}
```

```cpp
#include <hip/hip_runtime.h>
#include <hip/hip_cooperative_groups.h>
#include <cstdio>
#include <cstdint>
#include <cmath>

constexpr int DM = 1024, NB = 4, SEQ = 8192, T = NB * SEQ;
constexpr int HD = 64, NQH = 8, NKVH = 2, AW = 512, KVW = 128, WINDOW = 128, BLK = 128;
constexpr int CW = 512, INC = 2304, DFF = 2816, MEML = 256, XH = 4, XHD = 256, MROWS = NB * MEML;
constexpr float RMS_EPS = 1e-5f;
constexpr float LOG2E = 1.4426950408889634f;
constexpr float QSCALE = 0.125f * LOG2E;
constexpr float XSCALE = 0.0625f * LOG2E;

typedef unsigned short bf16_t;
__host__ __device__ __forceinline__ unsigned f2bf(float f) { unsigned u = __builtin_bit_cast(unsigned, f); return (u + 0x7fffu + ((u >> 16) & 1u)) >> 16; }
__host__ __device__ __forceinline__ float bf2f(unsigned h) { return __builtin_bit_cast(float, (h & 0xffffu) << 16); }

constexpr size_t MiB = 1u << 20;
constexpr size_t WS_CTL = 0;
constexpr size_t WS_W1I = 1 * MiB, WS_W1O = 12 * MiB, WS_WMI = 18 * MiB, WS_WMO = 23 * MiB, WS_WXQ = 25 * MiB, WS_WXKV = 27 * MiB, WS_WXO = 31 * MiB, WS_W2I = 33 * MiB, WS_W2O = 44 * MiB;
constexpr size_t WS_ROPE = 50 * MiB;
constexpr size_t WS_SS = 58 * MiB;
constexpr size_t WS_SSMEM = 68 * MiB;
constexpr size_t WS_GMO = 68 * MiB + 512 * 1024;
constexpr size_t WS_MEMB = 69 * MiB;
constexpr size_t WS_KVM = 71 * MiB;
constexpr size_t WS_HB = 76 * MiB;
constexpr size_t WS_G = 140 * MiB;
constexpr size_t WS_Q = 140 * MiB, WS_K = 172 * MiB, WS_V = 180 * MiB, WS_GB = 188 * MiB, WS_Z = 220 * MiB, WS_MIXED = 252 * MiB;
constexpr size_t WS_XQ = 140 * MiB, WS_XO = 204 * MiB;
constexpr size_t WS_END = 316 * MiB;
constexpr size_t WS_TMP = 316 * MiB;
constexpr size_t WS_NEED = 508 * MiB;
__host__ __device__ __forceinline__ size_t ws_ss(int i) { return WS_SS + (size_t)i * 2 * MiB; }
namespace pg8 {
#define PG8_LAS __attribute__((address_space(3)))
typedef unsigned short bf16_t;
typedef short bf16x8 __attribute__((ext_vector_type(8)));
typedef float f32x4 __attribute__((ext_vector_type(4)));
typedef unsigned u32x4 __attribute__((ext_vector_type(4)));
constexpr int BM = 256, BK = 64, HALF = 128, HTB = HALF * BK * 2  , STAGE_BYTES = 8 * HTB, NXCD = 8, WGM = 8;

__host__ __device__ __forceinline__ int lds_byte(int r, int c) { const int st = (r >> 4) * 2 + (c >> 5), rr = r & 15, cc = c & 31, ob = rr * 64 + cc * 2; return st * 1024 + (ob ^ (((ob >> 9) & 1) << 5)); }
__host__ __device__ __forceinline__ void stage_rc(int b, int& R, int& C) { const int st = b / 1024, sb = b % 1024, swz = sb ^ (((sb >> 9) & 1) << 5); R = (st >> 1) * 16 + swz / 64; C = (st & 1) * 32 + (swz % 64) / 2; }
__host__ __device__ __forceinline__ int perm32(int rho) { const int n = rho >> 4, i = rho & 15; return 8 * (i >> 2) + 4 * n + (i & 3); }

struct Unit { int pm, pn; };
struct Gemm { const bf16_t* A; const bf16_t* Bt; int M, N, K; };

struct StaticOrder {
    int nM, nN, nwg, G, c;
    __host__ __device__ void init(int M, int N, int G_, int c_) { nM = M / BM; nN = N / BM; nwg = nM * nN; G = G_; c = c_; }
    __host__ __device__ bool next(int i, Unit& u) const {
        const long L = (long)i * G + c; if (L >= nwg) return false;
        int wgid = (int)L; { const int q = nwg / NXCD, r = nwg % NXCD, xcd = wgid % NXCD, off = wgid / NXCD; wgid = (xcd < r ? xcd * (q + 1) : r * (q + 1) + (xcd - r) * q) + off; }
        const int nig = WGM * nN, gid = wgid / nig, fm = gid * WGM, gsz = (nM - fm) < WGM ? (nM - fm) : WGM;
        u.pm = fm + ((wgid % nig) % gsz); u.pn = (wgid % nig) / gsz; return true;
    }
    __device__ __forceinline__ void a_ready(const Unit&) const {}
    __device__ __forceinline__ void done(const Unit&) const {}
};
typedef float f32x2c_t __attribute__((ext_vector_type(2))); typedef __bf16 bf16x2c_t __attribute__((ext_vector_type(2)));
__device__ __forceinline__ unsigned cvt_pk_bf16(float lo, float hi) { f32x2c_t v = {lo, hi}; bf16x2c_t b = __builtin_convertvector(v, bf16x2c_t); return __builtin_bit_cast(unsigned, b); }
typedef float f32x2 __attribute__((ext_vector_type(2)));
template <class Epi, class Sched, bool ALIGN_EPI = false, bool SP2 = false>
__device__ __forceinline__ void gemm_phase(PG8_LAS unsigned char* lds, const Gemm g, const Sched& S, const Epi& E) {
    const int tid = threadIdx.x, wid = __builtin_amdgcn_readfirstlane(tid >> 6), lane = tid & 63, wr = wid >> 2, wc = wid & 3, fr = lane & 15, fq = lane >> 4;
    const int K = g.K, nt = K / BK;
    unsigned voffA[2], voffB[2];
#pragma unroll
    for (int i = 0; i < 2; ++i) { int R, C; stage_rc(tid * 16 + i * 8192, R, C); const int Rb = Epi::PERM ? ((R & ~31) + perm32(R & 31)) : R;
        voffA[i] = (unsigned)(R * K + C) * 2u; voffB[i] = (unsigned)(Rb * K + C) * 2u; }
    const size_t kstep = (size_t)(BK * 2);
    const size_t hstep = (size_t)HALF * K * 2;
    const size_t tstep = 2 * hstep;
    const unsigned ldsw = (unsigned)wid * 1024u;
    const int aoff = lds_byte(wr * 64 + fr, fq * 8), boff = lds_byte(wc * 32 + fr, fq * 8);
#define PG8_SA(b, h) (((b) * 2 + (h)) * HTB)
#define PG8_SB(b, h) ((4 + (b) * 2 + (h)) * HTB)
#define PG8_STAGE(bufoff, gbase, voff) do { _Pragma("unroll") for (int _i = 0; _i < 2; ++_i) \
        __builtin_amdgcn_global_load_lds((const unsigned*)((const char*)(gbase) + (voff)[_i]), (PG8_LAS unsigned*)(lds + (bufoff) + ldsw + _i * 8192), 16, 0, 0); } while (0)
#define PG8_LDA(dst, b, h) do { _Pragma("unroll") for (int m = 0; m < 4; ++m) _Pragma("unroll") for (int k = 0; k < 2; ++k) dst[m][k] = *(const PG8_LAS bf16x8*)(lds + PG8_SA(b, h) + aoff + m * 2048 + k * 1024); } while (0)
#define PG8_LDB(dst, b, h) do { _Pragma("unroll") for (int n = 0; n < 2; ++n) _Pragma("unroll") for (int k = 0; k < 2; ++k) dst[n][k] = *(const PG8_LAS bf16x8*)(lds + PG8_SB(b, h) + boff + n * 2048 + k * 1024); } while (0)
#define PG8_MMA(ai, bj, At, Bt) do { __builtin_amdgcn_s_setprio(1); _Pragma("unroll") for (int m = 0; m < 4; ++m) _Pragma("unroll") for (int n = 0; n < 2; ++n) _Pragma("unroll") for (int k = 0; k < 2; ++k) \
        acc[ai][bj][m][n] = __builtin_amdgcn_mfma_f32_16x16x32_bf16(Bt[n][k], At[m][k], acc[ai][bj][m][n], 0, 0, 0); __builtin_amdgcn_s_setprio(0); } while (0)
#define PG8_WAIT_V(n) asm volatile("s_waitcnt vmcnt(" #n ")" ::: "memory")
#define PG8_WAIT_L(n) asm volatile("s_waitcnt lgkmcnt(" #n ")" ::: "memory")
#define PG8_BAR __builtin_amdgcn_s_barrier()
#define PG8_SCHED __builtin_amdgcn_sched_barrier(0)
    Unit cur, nxt; int ui = 0;
    if (!S.next(0, cur)) return;
    f32x4 acc[2][2][4][2];
#pragma unroll
    for (int a = 0; a < 2; ++a)
#pragma unroll
        for (int b = 0; b < 2; ++b)
#pragma unroll
            for (int m = 0; m < 4; ++m)
#pragma unroll
                for (int n = 0; n < 2; ++n) acc[a][b][m][n] = (f32x4){0.f, 0.f, 0.f, 0.f};
    bf16x8 At[4][2], B0[2][2], B1[2][2];
    const char* cA = (const char*)g.A + (size_t)cur.pm * tstep; const char* cB = (const char*)g.Bt + (size_t)cur.pn * tstep;
    S.a_ready(cur);
    if constexpr (SP2) {
        PG8_STAGE(PG8_SB(0, 0), cB, voffB); PG8_STAGE(PG8_SB(0, 1), cB + hstep, voffB); PG8_STAGE(PG8_SA(0, 0), cA, voffA); PG8_STAGE(PG8_SA(0, 1), cA + hstep, voffA);
        if (wr == 1) PG8_BAR;
        PG8_WAIT_V(2); PG8_BAR;
        PG8_STAGE(PG8_SB(1, 0), cB + kstep, voffB); PG8_STAGE(PG8_SA(1, 0), cA + kstep, voffA); PG8_STAGE(PG8_SB(1, 1), cB + hstep + kstep, voffB);
        PG8_WAIT_V(6); PG8_BAR;
    } else {
        PG8_STAGE(PG8_SB(0, 0), cB, voffB); PG8_STAGE(PG8_SA(0, 0), cA, voffA); PG8_STAGE(PG8_SB(0, 1), cB + hstep, voffB); PG8_STAGE(PG8_SA(0, 1), cA + hstep, voffA);
        if (wr == 1) PG8_BAR;
        PG8_WAIT_V(4); PG8_BAR;
        PG8_STAGE(PG8_SB(1, 0), cB + kstep, voffB); PG8_STAGE(PG8_SA(1, 0), cA + kstep, voffA); PG8_STAGE(PG8_SB(1, 1), cB + hstep + kstep, voffB);
        PG8_WAIT_V(6); PG8_BAR;
    }
    for (;;) {
        const bool has_next = S.next(ui + 1, nxt);
        const char* nA = has_next ? (const char*)g.A + (size_t)nxt.pm * tstep : cA; const char* nB = has_next ? (const char*)g.Bt + (size_t)nxt.pn * tstep : cB;
        for (int t = 0; t < nt; t += 2) {
            const bool last = (t == nt - 2);
            const char* a1 = cA + (size_t)(t + 1) * kstep;
            const char* a2 = last ? nA : cA + (size_t)(t + 2) * kstep; const char* b2 = last ? nB : cB + (size_t)(t + 2) * kstep;
            const char* a3 = a2 + kstep; const char* b3 = b2 + kstep;
            if (last && has_next) S.a_ready(nxt);
            if constexpr (SP2) {
            PG8_LDB(B0, 0, 0); PG8_LDB(B1, 0, 1); PG8_SCHED; PG8_LDA(At, 0, 0); PG8_STAGE(PG8_SA(1, 1), a1 + hstep, voffA);
            PG8_WAIT_V(8); PG8_WAIT_L(0); PG8_BAR; PG8_MMA(0, 0, At, B0); PG8_MMA(0, 1, At, B1); PG8_BAR; PG8_SCHED;
            PG8_LDA(At, 0, 1); PG8_STAGE(PG8_SB(0, 0), b2, voffB); PG8_STAGE(PG8_SB(0, 1), b2 + hstep, voffB); PG8_STAGE(PG8_SA(0, 0), a2, voffA);
            PG8_WAIT_V(8); PG8_WAIT_L(0); PG8_BAR; PG8_MMA(1, 0, At, B0); PG8_MMA(1, 1, At, B1); PG8_BAR; PG8_SCHED;
            PG8_LDB(B0, 1, 0); PG8_LDB(B1, 1, 1); PG8_SCHED; PG8_LDA(At, 1, 0); PG8_STAGE(PG8_SA(0, 1), a2 + hstep, voffA);
            PG8_WAIT_V(8); PG8_WAIT_L(0); PG8_BAR; PG8_MMA(0, 0, At, B0); PG8_MMA(0, 1, At, B1); PG8_BAR; PG8_SCHED;
            PG8_LDA(At, 1, 1); PG8_STAGE(PG8_SB(1, 0), b3, voffB); PG8_STAGE(PG8_SB(1, 1), b3 + hstep, voffB); PG8_STAGE(PG8_SA(1, 0), a3, voffA);
            PG8_WAIT_V(8); PG8_WAIT_L(0); PG8_BAR; PG8_MMA(1, 0, At, B0); PG8_MMA(1, 1, At, B1); PG8_BAR; PG8_SCHED;
            } else {
            PG8_LDB(B0, 0, 0); PG8_SCHED; PG8_LDA(At, 0, 0); PG8_STAGE(PG8_SA(1, 1), a1 + hstep, voffA);
            PG8_WAIT_L(8); PG8_BAR; PG8_WAIT_L(0); PG8_MMA(0, 0, At, B0); PG8_BAR; PG8_SCHED;
            PG8_LDB(B1, 0, 1); PG8_STAGE(PG8_SB(0, 0), b2, voffB);
            PG8_BAR; PG8_WAIT_L(0); PG8_MMA(0, 1, At, B1); PG8_BAR;
            PG8_LDA(At, 0, 1); PG8_STAGE(PG8_SA(0, 0), a2, voffA);
            PG8_BAR; PG8_WAIT_L(0); PG8_MMA(1, 0, At, B0); PG8_BAR; PG8_SCHED;
            PG8_STAGE(PG8_SB(0, 1), b2 + hstep, voffB);
            PG8_WAIT_V(6); PG8_BAR; PG8_MMA(1, 1, At, B1); PG8_BAR;
            PG8_LDB(B0, 1, 0); PG8_SCHED; PG8_LDA(At, 1, 0); PG8_STAGE(PG8_SA(0, 1), a2 + hstep, voffA);
            PG8_WAIT_L(8); PG8_BAR; PG8_WAIT_L(0); PG8_MMA(0, 0, At, B0); PG8_BAR; PG8_SCHED;
            PG8_LDB(B1, 1, 1); PG8_STAGE(PG8_SB(1, 0), b3, voffB);
            PG8_BAR; PG8_WAIT_L(0); PG8_MMA(0, 1, At, B1); PG8_BAR;
            PG8_LDA(At, 1, 1); PG8_STAGE(PG8_SA(1, 0), a3, voffA);
            PG8_BAR; PG8_WAIT_L(0); PG8_MMA(1, 0, At, B0); PG8_BAR; PG8_SCHED;
            PG8_STAGE(PG8_SB(1, 1), b3 + hstep, voffB);
            PG8_WAIT_V(6); PG8_BAR; PG8_MMA(1, 1, At, B1); PG8_BAR;
            }
        }
        if constexpr (ALIGN_EPI) { if (wr == 0) PG8_BAR; }
        if constexpr (!Epi::AFTER_DRAIN) { E(acc, cur, wr, wc, fr, fq); S.done(cur); }
        if (!has_next) break;
#pragma unroll
        for (int a = 0; a < 2; ++a)
#pragma unroll
            for (int b = 0; b < 2; ++b)
#pragma unroll
                for (int m = 0; m < 4; ++m)
#pragma unroll
                    for (int n = 0; n < 2; ++n) acc[a][b][m][n] = (f32x4){0.f, 0.f, 0.f, 0.f};
        cur = nxt; cA = nA; cB = nB; ++ui;
        if constexpr (ALIGN_EPI) { if (wr == 1) PG8_BAR; }
    }
    PG8_WAIT_V(0);
    if constexpr (!ALIGN_EPI) { if (wr == 0) PG8_BAR; }
    PG8_BAR;
    if constexpr (Epi::AFTER_DRAIN) { E.fused(acc, cur, wr, wc, fr, fq, lds, wid, lane); S.done(cur); }
#undef PG8_SA
#undef PG8_SB
#undef PG8_STAGE
#undef PG8_LDA
#undef PG8_LDB
#undef PG8_MMA
#undef PG8_WAIT_V
#undef PG8_WAIT_L
#undef PG8_BAR
#undef PG8_SCHED
}

__device__ __forceinline__ float row_rstd(const float* ssp, int row, int fq) {
    const f32x4 p = *(const f32x4*)(ssp + (size_t)row * 16 + 4 * fq);
    float s = (p[0] + p[1]) + (p[2] + p[3]);
    s += __shfl_xor(s, 16); s += __shfl_xor(s, 32);
    return __builtin_amdgcn_rsqf(s * (1.0f / 1024.0f) + 1e-5f);
}
__device__ __forceinline__ u32x4 pack8(const float (&o)[8]) { u32x4 w; w.x = cvt_pk_bf16(o[0], o[1]); w.y = cvt_pk_bf16(o[2], o[3]); w.z = cvt_pk_bf16(o[4], o[5]); w.w = cvt_pk_bf16(o[6], o[7]); return w; }

struct EpiSwiGLU {
    static constexpr bool PERM = true, AFTER_DRAIN = false;
    bf16_t* G; const float* ssp;
    __device__ __forceinline__ void operator()(const f32x4 (&acc)[2][2][4][2], const Unit& u, int wr, int wc, int fr, int fq) const {
        const int row0 = u.pm * BM + wr * 64 + fr, col0 = u.pn * HALF + wc * 32 + 8 * fq;
#pragma unroll
        for (int ai = 0; ai < 2; ++ai)
#pragma unroll
            for (int m = 0; m < 4; ++m) {
                const int row = row0 + ai * HALF + m * 16; const float r = row_rstd(ssp, row, fq); float o[8];
#pragma unroll
                for (int n = 0; n < 2; ++n)
#pragma unroll
                    for (int e = 0; e < 4; ++e) { const float g = acc[ai][0][m][n][e] * r, up = acc[ai][1][m][n][e] * r;
                        o[4 * n + e] = g * __builtin_amdgcn_rcpf(1.0f + __builtin_amdgcn_exp2f(g * -1.4426950408889634f)) * up; }
                *(u32x4*)(G + (size_t)row * 2816 + col0) = pack8(o);
            }
    }
};
template <bool F32IN> struct EpiResid {
    static constexpr bool PERM = true, AFTER_DRAIN = false;
    const float* hin32; bf16_t* hb; float* ssp; float w;
    __device__ __forceinline__ void operator()(const f32x4 (&acc)[2][2][4][2], const Unit& u, int wr, int wc, int fr, int fq) const {
        const int row0 = u.pm * BM + wr * 64 + fr, col0 = u.pn * BM + wc * 32 + 8 * fq;
#pragma unroll
        for (int ai = 0; ai < 2; ++ai)
#pragma unroll
            for (int m = 0; m < 4; ++m) {
                const int row = row0 + ai * HALF + m * 16; float ss = 0.f;
#pragma unroll
                for (int bj = 0; bj < 2; ++bj) { const size_t off = (size_t)row * 1024 + col0 + bj * HALF;
                    f32x4 a0, a1;
                    if (F32IN) { a0 = *(const f32x4*)(hin32 + off); a1 = *(const f32x4*)(hin32 + off + 4); }
                    else { const u32x4 hv = *(const u32x4*)(hb + off);
                        a0 = (f32x4){__builtin_bit_cast(float, hv.x << 16), __builtin_bit_cast(float, hv.x & 0xffff0000u), __builtin_bit_cast(float, hv.y << 16), __builtin_bit_cast(float, hv.y & 0xffff0000u)};
                        a1 = (f32x4){__builtin_bit_cast(float, hv.z << 16), __builtin_bit_cast(float, hv.z & 0xffff0000u), __builtin_bit_cast(float, hv.w << 16), __builtin_bit_cast(float, hv.w & 0xffff0000u)}; }
                    const f32x4 v0 = a0 + acc[ai][bj][m][0] * w, v1 = a1 + acc[ai][bj][m][1] * w;
                    u32x4 pk; pk.x = cvt_pk_bf16(v0[0], v0[1]); pk.y = cvt_pk_bf16(v0[2], v0[3]); pk.z = cvt_pk_bf16(v1[0], v1[1]); pk.w = cvt_pk_bf16(v1[2], v1[3]);
                    *(u32x4*)(hb + off) = pk;
                    ss += (v0[0] * v0[0] + v0[1] * v0[1]) + (v0[2] * v0[2] + v0[3] * v0[3]) + (v1[0] * v1[0] + v1[1] * v1[1]) + (v1[2] * v1[2] + v1[3] * v1[3]); }
                ss += __shfl_xor(ss, 16); ss += __shfl_xor(ss, 32);
                if (fq == 0) ssp[(size_t)row * 16 + u.pn * 4 + wc] = ss;
                if (m & 1) asm volatile("" ::: "memory");
            }
    }
};
struct EpiMixIn {
    static constexpr bool PERM = true, AFTER_DRAIN = false;
    const float* ssp; const float* rope; bf16_t* Q; bf16_t* K; bf16_t* V; bf16_t* GB; bf16_t* Z;
    __device__ __forceinline__ void operator()(const f32x4 (&acc)[2][2][4][2], const Unit& u, int wr, int wc, int fr, int fq) const {
        const int row0 = u.pm * BM + wr * 64 + fr, pn = u.pn;
#pragma unroll
        for (int ai = 0; ai < 2; ++ai)
#pragma unroll
            for (int m = 0; m < 4; ++m) {
                const int row = row0 + ai * HALF + m * 16; const float r = row_rstd(ssp, row, fq);
                if (pn < 3) {
                    float t1[8], t2[8];
#pragma unroll
                    for (int n = 0; n < 2; ++n)
#pragma unroll
                        for (int e = 0; e < 4; ++e) { t1[4 * n + e] = acc[ai][0][m][n][e] * r; t2[4 * n + e] = acc[ai][1][m][n][e] * r; }
                    if (pn < 2 || wc < 2) {
                        const f32x4* rp = (const f32x4*)(rope + ((size_t)row * 32 + 8 * fq) * 2);
#pragma unroll
                        for (int i = 0; i < 4; ++i) { const f32x4 cs = rp[i];
                            { const float a = t1[2 * i], b = t2[2 * i]; t1[2 * i] = a * cs[0] - b * cs[1]; t2[2 * i] = b * cs[0] + a * cs[1]; }
                            { const float a = t1[2 * i + 1], b = t2[2 * i + 1]; t1[2 * i + 1] = a * cs[2] - b * cs[3]; t2[2 * i + 1] = b * cs[2] + a * cs[3]; } }
                    }
                    bf16_t* dst; float sc = 1.0f;
                    if (pn < 2) { dst = Q + (size_t)row * 512 + (4 * pn + wc) * 64 + 8 * fq; sc = 0.125f * 1.4426950408889634f; }
                    else if (wc < 2) dst = K + (size_t)row * 128 + wc * 64 + 8 * fq;
                    else dst = V + (size_t)row * 128 + (wc - 2) * 64 + 8 * fq;
#pragma unroll
                    for (int i = 0; i < 8; ++i) { t1[i] *= sc; t2[i] *= sc; }
                    *(u32x4*)dst = pack8(t1); *(u32x4*)(dst + 32) = pack8(t2);
                } else if (pn < 5) {
#pragma unroll
                    for (int bj = 0; bj < 2; ++bj) { float o[8];
#pragma unroll
                        for (int n = 0; n < 2; ++n)
#pragma unroll
                            for (int e = 0; e < 4; ++e) o[4 * n + e] = acc[ai][bj][m][n][e] * r;
                        *(u32x4*)(GB + (size_t)row * 512 + (pn - 3) * 256 + bj * HALF + wc * 32 + 8 * fq) = pack8(o); }
                } else {
                    float o[8];
#pragma unroll
                    for (int n = 0; n < 2; ++n)
#pragma unroll
                        for (int e = 0; e < 4; ++e) o[4 * n + e] = (acc[ai][0][m][n][e] * r) * (acc[ai][1][m][n][e] * r);
                    *(u32x4*)(Z + (size_t)row * 512 + (pn - 5) * HALF + wc * 32 + 8 * fq) = pack8(o);
                }
            }
    }
};
struct EpiScale {
    static constexpr bool PERM = true, AFTER_DRAIN = false;
    bf16_t* O; int ldo; const float* ssp; float scale;
    __device__ __forceinline__ void operator()(const f32x4 (&acc)[2][2][4][2], const Unit& u, int wr, int wc, int fr, int fq) const {
        const int row0 = u.pm * BM + wr * 64 + fr, col0 = u.pn * BM + wc * 32 + 8 * fq;
#pragma unroll
        for (int ai = 0; ai < 2; ++ai)
#pragma unroll
            for (int m = 0; m < 4; ++m) {
                const int row = row0 + ai * HALF + m * 16; const float r = row_rstd(ssp, row, fq) * scale;
#pragma unroll
                for (int bj = 0; bj < 2; ++bj) { float o[8];
#pragma unroll
                    for (int n = 0; n < 2; ++n)
#pragma unroll
                        for (int e = 0; e < 4; ++e) o[4 * n + e] = acc[ai][bj][m][n][e] * r;
                    *(u32x4*)(O + (size_t)row * ldo + col0 + bj * HALF) = pack8(o); }
            }
    }
};
struct ListOrder {
    int idx0, cnt, nN;
    __device__ bool next(int i, Unit& u) const { if (i >= cnt) return false; const int id = idx0 + i; u.pm = id / nN; u.pn = id % nN; return true; }
    __device__ __forceinline__ void a_ready(const Unit&) const {}
    __device__ __forceinline__ void done(const Unit&) const {}
};
}
namespace cg = cooperative_groups;
#define LAS __attribute__((address_space(3)))
#define GAS __attribute__((address_space(1)))
typedef unsigned v4u __attribute__((ext_vector_type(4)));
typedef unsigned v2u __attribute__((ext_vector_type(2)));
typedef float f32x4 __attribute__((ext_vector_type(4)));
typedef float f32x16 __attribute__((ext_vector_type(16)));
typedef short bf16x8 __attribute__((ext_vector_type(8)));
typedef short s16x4 __attribute__((ext_vector_type(4)));
#define LDS_WAIT() asm volatile("s_waitcnt lgkmcnt(0)" ::: "memory")
constexpr int NWAVES = 8, NTHR = 512;
constexpr int RING_BYTES = 131072, XTRA_OFF = RING_BYTES, LDS_BYTES = 147456;
constexpr int NPH = 12;

struct Args {
    const float* x; const float* mem; const int* pos; const float* g_ffn1; const float* w_ffn1_in; const float* w_ffn1_out; const float* g_mix; const float* w_mix_in;
    const float* sinks; const float* conv_w; const float* g_attn_out; const float* g_conv_out; const float* w_mix_out; const float* g_mem; const float* g_xattn;
    const float* w_xq; const float* w_xkv; const float* w_xo; const float* g_ffn2; const float* w_ffn2_in; const float* w_ffn2_out; const float* g_final;
    float* out; unsigned char* ws; int ph_lo, ph_hi;
};
__device__ __forceinline__ unsigned pk2(float lo, float hi) { return f2bf(lo) | (f2bf(hi) << 16); }
typedef float f32x2_t __attribute__((ext_vector_type(2))); typedef __bf16 bf16x2_t __attribute__((ext_vector_type(2)));
__device__ __forceinline__ unsigned cvtpk(float lo, float hi) { f32x2_t v = {lo, hi}; bf16x2_t b = __builtin_convertvector(v, bf16x2_t); return __builtin_bit_cast(unsigned, b); }
__device__ __forceinline__ float wave_sum(float v) {
#pragma unroll
    for (int o = 1; o < 64; o <<= 1) v += __shfl_xor(v, o);
    return v;
}
__device__ __forceinline__ int rowmap(int mode, int n0) {
    if (mode == 1) { const int bj = n0 >= DFF ? 1 : 0, jj = n0 - bj * DFF; return 256 * (jj >> 7) + 128 * bj + (jj & 127); }
    if (mode == 2) {
        if (n0 < 512) { const int hd = n0 >> 6, bj = (n0 >> 5) & 1; return 256 * (hd >> 2) + 128 * bj + 32 * (hd & 3); }
        if (n0 < 768) { const int c = n0 - 512, sl = c >> 6, bj = (c >> 5) & 1; return 512 + 128 * bj + 32 * sl; }
        if (n0 < 1280) return n0;
        const int c = n0 - 1280, bj = c >= 512 ? 1 : 0, cc = c - 512 * bj; return 1280 + 256 * (cc >> 7) + 128 * bj + (cc & 127);
    }
    return n0;
}
__device__ __forceinline__ void p0_transpose_item(const float* W, const float* gain, const float* gain2, int K, int N, bf16_t* WT, int mode, LAS float* scr, int item, int lane) {
    const int nblk = N / 32, kb = item / nblk, nb = item % nblk, k0 = 64 * kb, n0 = 32 * nb;
#pragma unroll 8
    for (int i = 0; i < 32; ++i) { const int kk = 2 * i + (lane >> 5), k = k0 + kk; float g = 1.0f; if (gain) g = (gain2 && k >= 512) ? gain2[k - 512] : gain[k];
        scr[kk * 33 + (lane & 31)] = W[(size_t)k * N + n0 + (lane & 31)] * g; }
    LDS_WAIT(); asm volatile("" ::: "memory");
    const int c = lane & 7, r0 = rowmap(mode, n0);
#pragma unroll
    for (int j = 0; j < 4; ++j) { const int n = (lane >> 3) + 8 * j; const LAS float* s = scr + (8 * c) * 33 + n;
        v4u o; o.x = pk2(s[0 * 33], s[1 * 33]); o.y = pk2(s[2 * 33], s[3 * 33]); o.z = pk2(s[4 * 33], s[5 * 33]); o.w = pk2(s[6 * 33], s[7 * 33]);
        *(v4u*)(WT + (size_t)(r0 + n) * K + k0 + 8 * c) = o; }
    LDS_WAIT(); asm volatile("" ::: "memory");
}
__device__ __forceinline__ void stats_row(const float* xrow, bf16_t* orow, float* ssrow, int lane) {
    const f32x4* xr = (const f32x4*)xrow + lane; f32x4 v[4]; float s = 0.f;
#pragma unroll
    for (int j = 0; j < 4; ++j) { v[j] = xr[64 * j]; s += (v[j].x * v[j].x + v[j].y * v[j].y) + (v[j].z * v[j].z + v[j].w * v[j].w); }
    s = wave_sum(s);
    v2u* o8 = (v2u*)orow + lane;
#pragma unroll
    for (int j = 0; j < 4; ++j) { v2u w; w.x = cvtpk(v[j].x, v[j].y); w.y = cvtpk(v[j].z, v[j].w); o8[64 * j] = w; }
    if (lane < 16) ssrow[lane] = lane == 0 ? s : 0.f;
}
__device__ __forceinline__ void phase_prep(const Args& a, LAS unsigned char* lds, int G, int vcu) {
    const int tid = threadIdx.x, lane = tid & 63, wave = __builtin_amdgcn_readfirstlane(tid >> 6);
    LAS float* scr = (LAS float*)(lds + wave * 16384);
    const int gw = vcu * NWAVES + wave, NGW = G * NWAVES;
    unsigned char* ws = a.ws;
    constexpr int I_FI = (DM / 64) * (2 * DFF / 32), I_FO = (DFF / 64) * (DM / 32), I_MI = (DM / 64) * (INC / 32), I_SQ = (DM / 64) * (DM / 32), I_KV = (DM / 64) * (2 * DM / 32);
    constexpr int NITEMS = 2 * I_FI + 2 * I_FO + I_MI + 3 * I_SQ + I_KV;
    for (int it = gw; it < NITEMS; it += NGW) {
        int r = it;
        if (r < I_FI) { p0_transpose_item(a.w_ffn1_in, a.g_ffn1, nullptr, DM, 2 * DFF, (bf16_t*)(ws + WS_W1I), 1, scr, r, lane); continue; } r -= I_FI;
        if (r < I_FI) { p0_transpose_item(a.w_ffn2_in, a.g_ffn2, nullptr, DM, 2 * DFF, (bf16_t*)(ws + WS_W2I), 1, scr, r, lane); continue; } r -= I_FI;
        if (r < I_FO) { p0_transpose_item(a.w_ffn1_out, nullptr, nullptr, DFF, DM, (bf16_t*)(ws + WS_W1O), 0, scr, r, lane); continue; } r -= I_FO;
        if (r < I_FO) { p0_transpose_item(a.w_ffn2_out, nullptr, nullptr, DFF, DM, (bf16_t*)(ws + WS_W2O), 0, scr, r, lane); continue; } r -= I_FO;
        if (r < I_MI) { p0_transpose_item(a.w_mix_in, a.g_mix, nullptr, DM, INC, (bf16_t*)(ws + WS_WMI), 2, scr, r, lane); continue; } r -= I_MI;
        if (r < I_SQ) { p0_transpose_item(a.w_mix_out, a.g_attn_out, a.g_conv_out, DM, DM, (bf16_t*)(ws + WS_WMO), 0, scr, r, lane); continue; } r -= I_SQ;
        if (r < I_SQ) { p0_transpose_item(a.w_xq, a.g_xattn, nullptr, DM, DM, (bf16_t*)(ws + WS_WXQ), 0, scr, r, lane); continue; } r -= I_SQ;
        if (r < I_SQ) { p0_transpose_item(a.w_xo, nullptr, nullptr, DM, DM, (bf16_t*)(ws + WS_WXO), 0, scr, r, lane); continue; } r -= I_SQ;
        p0_transpose_item(a.w_xkv, a.g_mem, nullptr, DM, 2 * DM, (bf16_t*)(ws + WS_WXKV), 0, scr, r, lane);
    }
    for (int m = gw; m < T + MROWS; m += NGW) {
        if (m < T) stats_row(a.x + (size_t)m * DM, (bf16_t*)(ws + WS_HB) + (size_t)m * DM, (float*)(ws + ws_ss(0)) + (size_t)m * 16, lane);
        else { const int r = m - T; stats_row(a.mem + (size_t)r * DM, (bf16_t*)(ws + WS_MEMB) + (size_t)r * DM, (float*)(ws + WS_SSMEM) + (size_t)r * 16, lane); }
    }
    float* rope = (float*)(ws + WS_ROPE);
    for (int i = (vcu * NTHR + tid); i < T * 32; i += G * NTHR) {
        const int row = i >> 5, d = i & 31;
        const double invf = exp2(-(double)d * (13.287712379549449 / 32.0));
        const double ang = (double)a.pos[row] * invf;
        const double kq = rint(ang * 0.15915494309189535); const double y = fma(-kq, 6.283185307179586, ang) - kq * 2.4492935982947064e-16;
        const float yf = (float)y;
        *(float2*)(rope + (size_t)i * 2) = make_float2(cosf(yf), sinf(yf));
    }
}
__device__ __forceinline__ int crow(int r, int hi) { return (r & 3) + 8 * (r >> 2) + 4 * hi; }
__device__ __forceinline__ s16x4 vtr(const LAS unsigned char* p) { typedef short v4i16_t __attribute__((ext_vector_type(4))); return __builtin_bit_cast(s16x4, __builtin_amdgcn_ds_read_tr16_b64_v4i16((LAS v4i16_t*)p)); }
#define MFMA32(A, B, C) __builtin_amdgcn_mfma_f32_32x32x16_bf16((A), (B), (C), 0, 0, 0)
__device__ __forceinline__ f32x16 mfma32z(bf16x8 a, bf16x8 b) { f32x16 r = __builtin_amdgcn_mfma_f32_32x32x16_bf16(a, b, f32x16{}, 0, 0, 0); asm volatile("" : "+v"(r) : "v"(a), "v"(b)); return r; }
__device__ __forceinline__ void phase_swa(const Args& a, LAS unsigned char* lds, int G, int vcu) {
    const int tid = threadIdx.x, lane = tid & 63, r32 = lane & 31, hi = lane >> 5, wid = __builtin_amdgcn_readfirstlane(tid >> 6);
    unsigned char* ws = a.ws;
    const bf16_t* Q = (const bf16_t*)(ws + WS_Q); const bf16_t* Kg = (const bf16_t*)(ws + WS_K); const bf16_t* Vg = (const bf16_t*)(ws + WS_V);
    const bf16_t* GB = (const bf16_t*)(ws + WS_GB); const bf16_t* Z = (const bf16_t*)(ws + WS_Z); bf16_t* MX = (bf16_t*)(ws + WS_MIXED);
    LAS float* SSX = (LAS float*)(lds + XTRA_OFF);
    const float sink2 = a.sinks[wid] * LOG2E;
    const int kvh = wid >> 2;
    for (int unit = vcu; unit < NB * (SEQ / BLK); unit += G) {
        const int b = unit / (SEQ / BLK), blk = unit % (SEQ / BLK); const size_t t0 = (size_t)b * SEQ + (size_t)blk * BLK;
#pragma unroll
        for (int kh = 0; kh < 2; ++kh)
#pragma unroll
            for (int kt = 0; kt < 4; ++kt) {
                v4u kv = (v4u){0u, 0u, 0u, 0u}, vv = (v4u){0u, 0u, 0u, 0u};
                if (blk > 0 || kt >= 2) {
                    const size_t kr = t0 - 128 + 64 * kt;
                    kv = *(const v4u*)(Kg + (kr + lane) * KVW + kh * 64 + wid * 8);
                    vv = *(const v4u*)(Vg + (kr + 16 * (wid & 3) + (lane >> 2)) * KVW + kh * 64 + (wid >> 2) * 32 + (lane & 3) * 8);
                }
                *(LAS v4u*)(lds + (kh * 4 + kt) * 8192 + wid * 1024 + lane * 16) = kv;
                *(LAS v4u*)(lds + 65536 + (kh * 4 + kt) * 8192 + wid * 1024 + lane * 16) = vv;
            }
        __syncthreads();
#pragma unroll
        for (int half = 0; half < 2; ++half) {
        v2u opk[2][2][4];
#pragma unroll
        for (int q2 = 0; q2 < 2; ++q2) { const int qs = 2 * half + q2;
            const bf16_t* Qw = Q + (t0 + 32 * qs + r32) * AW + wid * 64;
            bf16x8 qr[4];
#pragma unroll
            for (int d0 = 0; d0 < 4; ++d0) qr[d0] = *(const bf16x8*)(Qw + d0 * 16 + hi * 8);
            const int T0 = qs >> 1;
            f32x16 p[3][2];
#pragma unroll
            for (int i = 0; i < 3; ++i) {
                const LAS unsigned char* kb = lds + (kvh * 4 + T0 + i) * 8192 + hi * 1024 + r32 * 16;
#pragma unroll
                for (int d0 = 0; d0 < 4; ++d0) {
                    const bf16x8 b0 = *(const LAS bf16x8*)(kb + d0 * 2048), b1 = *(const LAS bf16x8*)(kb + d0 * 2048 + 512);
                    if (d0 == 0) { p[i][0] = mfma32z(b0, qr[0]); p[i][1] = mfma32z(b1, qr[0]); }
                    else { p[i][0] = MFMA32(b0, qr[d0], p[i][0]); p[i][1] = MFMA32(b1, qr[d0], p[i][1]); }
                }
            }
            const int qi = 32 * qs + r32; float mx = sink2;
#pragma unroll
            for (int i = 0; i < 3; ++i)
#pragma unroll
                for (int h2 = 0; h2 < 2; ++h2)
#pragma unroll
                    for (int r = 0; r < 16; ++r) { const int ki = 64 * (T0 + i) + 32 * h2 + crow(r, hi);
                        const bool ok = (ki > qi) && (ki <= qi + 128) && (blk > 0 || ki >= 128);
                        const float s = ok ? p[i][h2][r] : -1e30f; p[i][h2][r] = s; mx = fmaxf(mx, s); }
            mx = fmaxf(mx, __shfl_xor(mx, 32));
            float l = 0.f;
#pragma unroll
            for (int i = 0; i < 3; ++i)
#pragma unroll
                for (int h2 = 0; h2 < 2; ++h2)
#pragma unroll
                    for (int r = 0; r < 16; ++r) { const float e = __builtin_amdgcn_exp2f(p[i][h2][r] - mx); p[i][h2][r] = e; l += e; }
            l += __shfl_xor(l, 32); l += __builtin_amdgcn_exp2f(sink2 - mx);
            const float rl = 1.0f / l;
            f32x16 oT[2];
#pragma unroll
            for (int i = 0; i < 3; ++i) {
                const LAS unsigned char* vp = lds + 65536 + (kvh * 4 + T0 + i) * 8192 + ((lane >> 4) & 1) * 32 + (lane & 3) * 8 + (4 * hi + ((lane & 15) >> 2)) * 64;
#pragma unroll
                for (int ks = 0; ks < 4; ++ks) {
                    const f32x16& ps = p[i][ks >> 1]; const int rb = (ks & 1) * 8;
                    v4u pw; pw.x = cvtpk(ps[rb + 0], ps[rb + 1]); pw.y = cvtpk(ps[rb + 2], ps[rb + 3]); pw.z = cvtpk(ps[rb + 4], ps[rb + 5]); pw.w = cvtpk(ps[rb + 6], ps[rb + 7]);
                    const bf16x8 pf = __builtin_bit_cast(bf16x8, pw);
#pragma unroll
                    for (int d0 = 0; d0 < 2; ++d0) {
                        const s16x4 lo = vtr(vp + d0 * 4096 + ks * 1024), hh = vtr(vp + d0 * 4096 + ks * 1024 + 512);
                        const bf16x8 vf = (bf16x8){lo[0], lo[1], lo[2], lo[3], hh[0], hh[1], hh[2], hh[3]};
                        if (i == 0 && ks == 0) oT[d0] = mfma32z(vf, pf); else oT[d0] = MFMA32(vf, pf, oT[d0]);
                    }
                }
            }
            float ss = 0.f;
#pragma unroll
            for (int d0 = 0; d0 < 2; ++d0)
#pragma unroll
                for (int r = 0; r < 16; ++r) { const float o = oT[d0][r] * rl; oT[d0][r] = o; ss += o * o; }
            ss += __shfl_xor(ss, 32);
            if (hi == 0) SSX[(32 * qs + r32) * 8 + wid] = ss;
#pragma unroll
            for (int d0 = 0; d0 < 2; ++d0)
#pragma unroll
                for (int g = 0; g < 4; ++g) { v2u w; w.x = cvtpk(oT[d0][4 * g], oT[d0][4 * g + 1]); w.y = cvtpk(oT[d0][4 * g + 2], oT[d0][4 * g + 3]); opk[q2][d0][g] = w; }
        }
        __syncthreads();
#pragma unroll
        for (int q2 = 0; q2 < 2; ++q2) { const int qs = 2 * half + q2;
            const f32x4 s0 = *(const LAS f32x4*)(SSX + (32 * qs + r32) * 8), s1 = *(const LAS f32x4*)(SSX + (32 * qs + r32) * 8 + 4);
            const float tot = ((s0[0] + s0[1]) + (s0[2] + s0[3])) + ((s1[0] + s1[1]) + (s1[2] + s1[3]));
            const float ra = __builtin_amdgcn_rsqf(tot * (1.0f / AW) + RMS_EPS);
            bf16_t* dst = MX + (t0 + 32 * qs + r32) * DM + wid * 64 + 4 * hi;
#pragma unroll
            for (int d0 = 0; d0 < 2; ++d0)
#pragma unroll
                for (int g = 0; g < 4; ++g) { const v2u w = opk[q2][d0][g]; v2u o;
                    o.x = cvtpk(bf2f(w.x) * ra, bf2f(w.x >> 16) * ra); o.y = cvtpk(bf2f(w.y) * ra, bf2f(w.y >> 16) * ra);
                    *(v2u*)(dst + 32 * d0 + 8 * g) = o; }
        }
        }
        {
            const int c0 = 8 * lane; float cw[3][8];
#pragma unroll
            for (int j = 0; j < 3; ++j) { const f32x4 w0 = *(const f32x4*)(a.conv_w + j * CW + c0), w1 = *(const f32x4*)(a.conv_w + j * CW + c0 + 4);
                cw[j][0] = w0[0]; cw[j][1] = w0[1]; cw[j][2] = w0[2]; cw[j][3] = w0[3]; cw[j][4] = w1[0]; cw[j][5] = w1[1]; cw[j][6] = w1[2]; cw[j][7] = w1[3]; }
            const size_t tw = t0 + 16 * wid; const int s0 = blk * BLK + 16 * wid;
            v4u z2 = (v4u){0u, 0u, 0u, 0u}, z1 = (v4u){0u, 0u, 0u, 0u};
            if (s0 >= 2) z2 = *(const v4u*)(Z + (tw - 2) * CW + c0);
            if (s0 >= 1) z1 = *(const v4u*)(Z + (tw - 1) * CW + c0);
            for (int tt = 0; tt < 16; ++tt) {
                const v4u z0 = *(const v4u*)(Z + (tw + tt) * CW + c0), gb = *(const v4u*)(GB + (tw + tt) * CW + c0);
                float y[8]; float ss = 0.f;
#pragma unroll
                for (int e = 0; e < 4; ++e) {
                    const unsigned a2 = z2[e], a1 = z1[e], a0 = z0[e], gg = gb[e];
                    const float ylo = (cw[0][2 * e] * bf2f(a2) + cw[1][2 * e] * bf2f(a1) + cw[2][2 * e] * bf2f(a0)) * bf2f(gg);
                    const float yhi = (cw[0][2 * e + 1] * bf2f(a2 >> 16) + cw[1][2 * e + 1] * bf2f(a1 >> 16) + cw[2][2 * e + 1] * bf2f(a0 >> 16)) * bf2f(gg >> 16);
                    y[2 * e] = ylo; y[2 * e + 1] = yhi; ss += ylo * ylo + yhi * yhi;
                }
                ss = wave_sum(ss); const float rc = __builtin_amdgcn_rsqf(ss * (1.0f / CW) + RMS_EPS);
                v4u o; o.x = cvtpk(y[0] * rc, y[1] * rc); o.y = cvtpk(y[2] * rc, y[3] * rc); o.z = cvtpk(y[4] * rc, y[5] * rc); o.w = cvtpk(y[6] * rc, y[7] * rc);
                *(v4u*)(MX + (tw + tt) * DM + AW + c0) = o;
                z2 = z1; z1 = z0;
            }
        }
        __syncthreads();
    }
}
__device__ __forceinline__ void phase_xattn(const Args& a, LAS unsigned char* lds, int G, int vcu) {
    const int tid0 = threadIdx.x, wid = __builtin_amdgcn_readfirstlane(tid0 >> 6);
    unsigned char* ws = a.ws;
    const bf16_t* XQ = (const bf16_t*)(ws + WS_XQ); const bf16_t* KVM = (const bf16_t*)(ws + WS_KVM); bf16_t* XO = (bf16_t*)(ws + WS_XO);
    for (int unit = vcu; unit < (T / 256) * XH; unit += G) {
        int tid = tid0; asm volatile("" : "+v"(tid));
        const int lane = tid & 63, r32 = lane & 31, hi = lane >> 5;
        const int pm = unit / XH, h = unit % XH; const size_t t0 = (size_t)pm * 256; const int b = (int)(t0 / SEQ);
        const bf16_t* Kh = KVM + (size_t)(b * MEML) * 2 * DM + h * XHD; const bf16_t* Vh = Kh + DM;
        {   const int mq = tid >> 5, c = tid & 31;
            const unsigned loff = (unsigned)(mq * (2 * DM * 2) + c * 16);
            LAS unsigned char* d0p = lds + mq * 512 + ((c ^ mq) << 4); LAS unsigned char* d1p = lds + mq * 512 + (((c ^ mq) ^ 16) << 4);
#pragma unroll
            for (int i = 0; i < 16; ++i) { GAS const char* bp = (GAS const char*)Kh + (size_t)i * (16 * 2 * DM * 2); asm("" : "+s"(bp)); const v4u v = *(GAS const v4u*)(bp + loff); *(LAS v4u*)(((i & 1) ? d1p : d0p) + i * 8192) = v; } }
        const bf16_t* Qw = XQ + (t0 + 32 * wid + r32) * DM + h * XHD + hi * 8;
        __syncthreads();
        v4u pw[16]; float l = 0.f, m_run = -1e30f, f0 = 1.0f;
#pragma unroll
        for (int ps = 0; ps < 2; ++ps) {
            __builtin_amdgcn_sched_barrier(0);
            bf16x8 qc[4], qn[4];
#pragma unroll
            for (int dd = 0; dd < 4; ++dd) qc[dd] = *(const bf16x8*)(Qw + dd * 16);
            f32x16 p[4];
#pragma unroll
            for (int g = 0; g < 4; ++g) {
                if (g < 3) {
#pragma unroll
                    for (int dd = 0; dd < 4; ++dd) qn[dd] = *(const bf16x8*)(Qw + (4 * g + 4 + dd) * 16);
                }
#pragma unroll
                for (int dd = 0; dd < 4; ++dd) {
                    const int d0 = 4 * g + dd; unsigned ab = (unsigned)(ps * 65536 + r32 * 512 + (((2 * d0 + hi) ^ r32) << 4));
                    asm volatile("" : "+v"(ab));
#pragma unroll
                    for (int j = 0; j < 4; ++j) { const bf16x8 kf = *(const LAS bf16x8*)(lds + ab + j * 16384); if (d0 == 0) p[j] = mfma32z(kf, qc[0]); else p[j] = MFMA32(kf, qc[dd], p[j]); }
                }
                __builtin_amdgcn_sched_barrier(0);
#pragma unroll
                for (int dd = 0; dd < 4; ++dd) qc[dd] = qn[dd];
            }
            __builtin_amdgcn_sched_barrier(0);
            float mx = -1e30f;
#pragma unroll
            for (int j = 0; j < 4; ++j)
#pragma unroll
                for (int r = 0; r < 16; ++r) mx = fmaxf(mx, p[j][r]);
            mx = fmaxf(mx, __shfl_xor(mx, 32));
            const float mnew = fmaxf(m_run, mx);
            if (ps == 1) { f0 = __builtin_amdgcn_exp2f(m_run - mnew); l *= f0; }
            m_run = mnew;
            float ls = 0.f;
#pragma unroll
            for (int j = 0; j < 4; ++j) {
#pragma unroll
                for (int r = 0; r < 16; ++r) { const float e = __builtin_amdgcn_exp2f(p[j][r] - mnew); p[j][r] = e; ls += e; }
                v4u w0, w1;
                w0.x = cvtpk(p[j][0], p[j][1]); w0.y = cvtpk(p[j][2], p[j][3]); w0.z = cvtpk(p[j][4], p[j][5]); w0.w = cvtpk(p[j][6], p[j][7]);
                w1.x = cvtpk(p[j][8], p[j][9]); w1.y = cvtpk(p[j][10], p[j][11]); w1.z = cvtpk(p[j][12], p[j][13]); w1.w = cvtpk(p[j][14], p[j][15]);
                pw[8 * ps + 2 * j] = w0; pw[8 * ps + 2 * j + 1] = w1;
                __builtin_amdgcn_sched_barrier(0);
            }
            l += ls;
            __builtin_amdgcn_sched_barrier(0);
        }
        l += __shfl_xor(l, 32); const float rl = 1.0f / l;
        __syncthreads();
        {   const int mq = tid >> 5, c = tid & 31;
            const unsigned loff = (unsigned)(mq * (2 * DM * 2) + c * 16); LAS unsigned char* dp = lds + (c >> 2) * 16384 + mq * 64 + (c & 3) * 16;
#pragma unroll
            for (int i = 0; i < 16; ++i) { GAS const char* bp = (GAS const char*)Vh + (size_t)i * (16 * 2 * DM * 2); asm("" : "+s"(bp)); const v4u v = *(GAS const v4u*)(bp + loff); *(LAS v4u*)(dp + i * 1024) = v; } }
        __syncthreads();
        const LAS unsigned char* vp = lds + ((lane >> 4) & 1) * 32 + (lane & 3) * 8 + (4 * hi + ((lane & 15) >> 2)) * 64;
        bf16_t* dst = XO + (t0 + 32 * wid + r32) * DM + h * XHD + 4 * hi;
#pragma unroll
        for (int db = 0; db < 8; ++db) {
            f32x16 o;
            unsigned vb = (unsigned)(db * 16384); asm volatile("" : "+v"(vb));
#pragma unroll
            for (int ks = 0; ks < 16; ++ks) {
                const s16x4 lo = vtr(vp + vb + ks * 1024), hh = vtr(vp + vb + ks * 1024 + 512);
                const bf16x8 vf = (bf16x8){lo[0], lo[1], lo[2], lo[3], hh[0], hh[1], hh[2], hh[3]};
                if (ks == 0) o = mfma32z(vf, __builtin_bit_cast(bf16x8, pw[0])); else o = MFMA32(vf, __builtin_bit_cast(bf16x8, pw[ks]), o);
                if (ks == 7) {
#pragma unroll
                    for (int r = 0; r < 16; ++r) o[r] *= f0;
                }
            }
#pragma unroll
            for (int g = 0; g < 4; ++g) { v2u w; w.x = cvtpk(o[4 * g] * rl, o[4 * g + 1] * rl); w.y = cvtpk(o[4 * g + 2] * rl, o[4 * g + 3] * rl); *(v2u*)(dst + 32 * db + 8 * g) = w; }
        }
        __syncthreads();
    }
}
__device__ __forceinline__ void phase_final(const Args& a, int G, int vcu) {
    const int tid = threadIdx.x, lane = tid & 63, wave = tid >> 6;
    const float* ssp = (const float*)(a.ws + ws_ss(4)); const bf16_t* HB = (const bf16_t*)(a.ws + WS_HB);
    f32x4 gv[4];
#pragma unroll
    for (int j = 0; j < 2; ++j) { gv[2 * j] = *(const f32x4*)(a.g_final + 512 * j + 8 * lane); gv[2 * j + 1] = *(const f32x4*)(a.g_final + 512 * j + 8 * lane + 4); }
    for (int m = vcu * NWAVES + wave; m < T; m += G * NWAVES) {
        const f32x4 p0 = *(const f32x4*)(ssp + (size_t)m * 16), p1 = *(const f32x4*)(ssp + (size_t)m * 16 + 4), p2 = *(const f32x4*)(ssp + (size_t)m * 16 + 8), p3 = *(const f32x4*)(ssp + (size_t)m * 16 + 12);
        const float s = (((p0[0] + p0[1]) + (p0[2] + p0[3])) + ((p1[0] + p1[1]) + (p1[2] + p1[3]))) + (((p2[0] + p2[1]) + (p2[2] + p2[3])) + ((p3[0] + p3[1]) + (p3[2] + p3[3])));
        const float r = 1.0f / sqrtf(s * (1.0f / DM) + RMS_EPS);
#pragma unroll
        for (int j = 0; j < 2; ++j) { const v4u hv = *(const v4u*)(HB + (size_t)m * DM + 512 * j + 8 * lane);
            f32x4 o0 = (f32x4){bf2f(hv.x), bf2f(hv.x >> 16), bf2f(hv.y), bf2f(hv.y >> 16)}, o1 = (f32x4){bf2f(hv.z), bf2f(hv.z >> 16), bf2f(hv.w), bf2f(hv.w >> 16)};
            o0 = o0 * r * gv[2 * j]; o1 = o1 * r * gv[2 * j + 1];
            float* op = a.out + (size_t)m * DM + 512 * j + 8 * lane; *(f32x4*)op = o0; *(f32x4*)(op + 4) = o1; }
    }
}
#define XB_TMO      128
#define XB_XCNT(j)  (256  + 64 * (j))
#define XB_XSUB(j)  (1280 + 64 * (j))
#define XB_XGEN(j)  (2304 + 64 * (j))
#define XB_TOP      3328
#define XB_TOPGEN   3392
#define XCD_BAR_WORDS 3456
#define XB_SPIN_CAP (1u << 18)

__device__ __forceinline__ unsigned xb_ld(unsigned* p)              { return __hip_atomic_load(p, __ATOMIC_RELAXED, __HIP_MEMORY_SCOPE_AGENT); }
__device__ __forceinline__ unsigned xb_add(unsigned* p, unsigned v) { return __hip_atomic_fetch_add(p, v, __ATOMIC_RELAXED, __HIP_MEMORY_SCOPE_AGENT); }
__device__ __forceinline__ unsigned xb_xcc_id() { return (unsigned)__builtin_amdgcn_s_getreg((3 << 11) | 20) & 0xFu; }
#define XB_SPIN(cond, bar) do { unsigned _sp = 0; while (cond) { __builtin_amdgcn_s_sleep(1); \
    if ((++_sp & 255u) == 0u) { if (xb_ld(&(bar)[XB_TMO])) break; if (_sp > XB_SPIN_CAP) { atomicAdd(&(bar)[XB_TMO], 1u); break; } } } } while (0)

struct XcdBarrier {
    unsigned* bar; unsigned x;
    volatile LAS unsigned* st;
};

__device__ __forceinline__ XcdBarrier xcd_barrier_post(unsigned* bar, volatile LAS unsigned* st) {
    XcdBarrier b; b.bar = bar; b.x = xb_xcc_id(); b.st = st;
    if (threadIdx.x == 0) (void)xb_add(&bar[XB_XCNT(b.x)], 1u);
    return b;
}
__device__ __forceinline__ void xcd_barrier_complete(unsigned* bar, unsigned x, unsigned& nloc, unsigned& nx) {
    const unsigned G = gridDim.x * gridDim.y * gridDim.z;
    unsigned sum, cnt, mine, sp = 0u;
    for (;;) {
        sum = 0u; cnt = 0u; mine = 0u;
#pragma unroll
        for (unsigned j = 0; j < 16; ++j) { const unsigned c = xb_ld(&bar[XB_XCNT(j)]); sum += c; cnt += (c > 0u) ? 1u : 0u; mine = (j == x) ? c : mine; }
        if (sum == G) break;
        __builtin_amdgcn_s_sleep(1);
        if ((++sp & 255u) == 0u) { if (xb_ld(&bar[XB_TMO])) break; if (sp > XB_SPIN_CAP) { atomicAdd(&bar[XB_TMO], 1u); break; } }
    }
    nloc = mine > 0u ? mine : 1u; nx = cnt > 0u ? cnt : 1u;
}

__device__ __forceinline__ void xcd_barrier(const XcdBarrier& b) {
    asm volatile("s_waitcnt vmcnt(0)" ::: "memory");
    __syncthreads();
    if (threadIdx.x == 0) {
        unsigned* bar = b.bar;
        __builtin_amdgcn_s_waitcnt(0);
        unsigned nloc = b.st[0], nx = b.st[1];
        if (nloc == 0u) { xcd_barrier_complete(bar, b.x, nloc, nx); b.st[0] = nloc; b.st[1] = nx; }
        const unsigned old = xb_add(&bar[XB_XSUB(b.x)], 1u);
        const unsigned gen = old / nloc;
        if (old + 1u == (gen + 1u) * nloc) {
            __builtin_amdgcn_fence(__ATOMIC_RELEASE, "agent");
            asm volatile("s_waitcnt vmcnt(0)" ::: "memory");
            const unsigned og = xb_add(&bar[XB_TOP], 1u);
            const unsigned tg = og / nx;
            if (og + 1u == (tg + 1u) * nx) xb_add(&bar[XB_TOPGEN], 1u);
            else XB_SPIN(xb_ld(&bar[XB_TOPGEN]) == tg, bar);
            __builtin_amdgcn_fence(__ATOMIC_ACQUIRE, "agent");
            xb_add(&bar[XB_XGEN(b.x)], 1u);
            asm volatile("s_waitcnt vmcnt(0)" ::: "memory");
        } else {
            XB_SPIN(xb_ld(&bar[XB_XGEN(b.x)]) == gen, bar);
            __builtin_amdgcn_fence(__ATOMIC_ACQUIRE, "agent");
            asm volatile("s_waitcnt vmcnt(0)" ::: "memory");
        }
    }
    __syncthreads();
}

#define GEMM_PHASE(EPI, SCHED, g, S, E) pg8::gemm_phase<EPI, SCHED, true, true>(lds, g, S, E)
__device__ __forceinline__ void ph_ffn_in(LAS unsigned char* lds, unsigned char* ws, int G, int bx, size_t wofs, int ssi) {
    pg8::Gemm g{(const bf16_t*)(ws + WS_HB), (const bf16_t*)(ws + wofs), T, 2 * DFF, DM}; pg8::StaticOrder S; S.init(T, 2 * DFF, G, bx);
    pg8::EpiSwiGLU E{(bf16_t*)(ws + WS_G), (const float*)(ws + ws_ss(ssi))};
    GEMM_PHASE(pg8::EpiSwiGLU, pg8::StaticOrder, g, S, E);
}
template <bool F32IN> __device__ __forceinline__ void ph_resid(LAS unsigned char* lds, unsigned char* ws, int G, int bx, size_t aofs, size_t wofs, int K, const float* hin32, int sso, float w) {
    pg8::Gemm g{(const bf16_t*)(ws + aofs), (const bf16_t*)(ws + wofs), T, DM, K}; pg8::StaticOrder S; S.init(T, DM, G, bx);
    pg8::EpiResid<F32IN> E{hin32, (bf16_t*)(ws + WS_HB), (float*)(ws + ws_ss(sso)), w};
    GEMM_PHASE(pg8::EpiResid<F32IN>, pg8::StaticOrder, g, S, E);
}
__device__ __forceinline__ void ph_mix_in(LAS unsigned char* lds, unsigned char* ws, int G, int bx) {
    { pg8::Gemm g{(const bf16_t*)(ws + WS_HB), (const bf16_t*)(ws + WS_WMI), T, INC, DM}; pg8::StaticOrder S; S.init(T, INC, G, bx);
      pg8::EpiMixIn E{(const float*)(ws + ws_ss(1)), (const float*)(ws + WS_ROPE), (bf16_t*)(ws + WS_Q), (bf16_t*)(ws + WS_K), (bf16_t*)(ws + WS_V), (bf16_t*)(ws + WS_GB), (bf16_t*)(ws + WS_Z)};
      GEMM_PHASE(pg8::EpiMixIn, pg8::StaticOrder, g, S, E); }
    { int idx0, cnt;
      if (G == 256) { idx0 = bx - 128; cnt = (bx >= 128 && bx < 160) ? 1 : 0; }
      else { const int per = (32 + G - 1) / G; idx0 = bx * per; cnt = idx0 >= 32 ? 0 : (idx0 + per <= 32 ? per : 32 - idx0); }
      pg8::ListOrder S{idx0, cnt, 8};
      pg8::Gemm g{(const bf16_t*)(ws + WS_MEMB), (const bf16_t*)(ws + WS_WXKV), MROWS, 2 * DM, DM};
      pg8::EpiScale E{(bf16_t*)(ws + WS_KVM), 2 * DM, (const float*)(ws + WS_SSMEM), 1.0f};
      GEMM_PHASE(pg8::EpiScale, pg8::ListOrder, g, S, E); }
}
__device__ __forceinline__ void ph_xq(LAS unsigned char* lds, unsigned char* ws, int G, int bx) {
    pg8::Gemm g{(const bf16_t*)(ws + WS_HB), (const bf16_t*)(ws + WS_WXQ), T, DM, DM}; pg8::StaticOrder S; S.init(T, DM, G, bx);
    pg8::EpiScale E{(bf16_t*)(ws + WS_XQ), DM, (const float*)(ws + ws_ss(2)), XSCALE};
    GEMM_PHASE(pg8::EpiScale, pg8::StaticOrder, g, S, E);
}
#ifndef PHMASK
#define PHMASK 0xFFF
#endif
#ifndef REPEAT_PH
#define REPEAT_PH -1
#endif
__global__ void __launch_bounds__(NTHR, 2) mk_fwd(Args a) {
    extern __shared__ __attribute__((aligned(16))) unsigned char lds_raw[];
    LAS unsigned char* lds = (LAS unsigned char*)lds_raw;
    const int G = gridDim.x, bx = blockIdx.x, vcu = (G % 8 == 0) ? (bx % 8) * (G / 8) + bx / 8 : bx;
    unsigned char* ws = a.ws;
    const int lo = a.ph_lo, hi = a.ph_hi;
#define IN(k) (((PHMASK >> (k)) & 1) && lo <= (k) && (k) < hi)
    volatile LAS unsigned* bst = (volatile LAS unsigned*)(lds + XTRA_OFF + 8192);
    if (threadIdx.x < 2) bst[threadIdx.x] = 0u;
    if (bx == 0 && lo == 0) { unsigned* bw = (unsigned*)(ws + WS_CTL); for (int i = threadIdx.x; i < XCD_BAR_WORDS; i += NTHR) bw[i] = 0u; }
    __syncthreads();
    XcdBarrier bar; bar.bar = (unsigned*)(ws + WS_CTL); bar.x = 0; bar.st = bst;
#define SEAM(k) do { if (IN(k) && IN((k) + 1)) xcd_barrier(bar); } while (0)
#define RUN(k, CALL) do { if (IN(k)) { CALL; if (REPEAT_PH == (k)) { xcd_barrier(bar); CALL; } } } while (0)
#ifdef EXTRA_SYNCS
    if (lo > 100) for (int i = 0; i < EXTRA_SYNCS; ++i) cg::this_grid().sync();
#endif
    if (IN(0)) phase_prep(a, lds, G, vcu);
    if (IN(0) && IN(1)) { cg::this_grid().sync(); bar = xcd_barrier_post((unsigned*)(ws + WS_CTL), bst); }
#ifdef EXTRA_SYNCS
    for (int i = 0; i < EXTRA_SYNCS; ++i) xcd_barrier(bar);
#endif
    RUN(1, ph_ffn_in(lds, ws, G, bx, WS_W1I, 0));
    SEAM(1);
    RUN(2, ph_resid<true>(lds, ws, G, bx, WS_G, WS_W1O, DFF, a.x, 1, 0.5f));
    SEAM(2);
    RUN(3, ph_mix_in(lds, ws, G, bx));
    SEAM(3);
    RUN(4, phase_swa(a, lds, G, vcu));
    SEAM(4);
    RUN(5, ph_resid<false>(lds, ws, G, bx, WS_MIXED, WS_WMO, DM, nullptr, 2, 1.0f));
    SEAM(5);
    RUN(6, ph_xq(lds, ws, G, bx));
    SEAM(6);
    RUN(7, phase_xattn(a, lds, G, vcu));
    SEAM(7);
    RUN(8, ph_resid<false>(lds, ws, G, bx, WS_XO, WS_WXO, DM, nullptr, 3, 1.0f));
    SEAM(8);
    RUN(9, ph_ffn_in(lds, ws, G, bx, WS_W2I, 3));
    SEAM(9);
    RUN(10, ph_resid<false>(lds, ws, G, bx, WS_G, WS_W2O, DFF, nullptr, 4, 0.5f));
    SEAM(10);
    RUN(11, phase_final(a, G, vcu));
#undef IN
#undef SEAM
#undef RUN
}
static void fill_args(Args& a, void* const* d_in, void* d_out, void* d_ws) {
    a.x = (const float*)d_in[0]; a.mem = (const float*)d_in[1]; a.pos = (const int*)d_in[2]; a.g_ffn1 = (const float*)d_in[3]; a.w_ffn1_in = (const float*)d_in[4]; a.w_ffn1_out = (const float*)d_in[5];
    a.g_mix = (const float*)d_in[6]; a.w_mix_in = (const float*)d_in[7]; a.sinks = (const float*)d_in[8]; a.conv_w = (const float*)d_in[9]; a.g_attn_out = (const float*)d_in[10]; a.g_conv_out = (const float*)d_in[11];
    a.w_mix_out = (const float*)d_in[12]; a.g_mem = (const float*)d_in[13]; a.g_xattn = (const float*)d_in[14]; a.w_xq = (const float*)d_in[15]; a.w_xkv = (const float*)d_in[16]; a.w_xo = (const float*)d_in[17];
    a.g_ffn2 = (const float*)d_in[18]; a.w_ffn2_in = (const float*)d_in[19]; a.w_ffn2_out = (const float*)d_in[20]; a.g_final = (const float*)d_in[21];
    a.out = (float*)d_out; a.ws = (unsigned char*)d_ws;
}
extern "C" void kernel_launch(void* const* d_in, const int* in_sizes, int n_in, void* d_out, int out_size, void* d_ws, size_t ws_size, hipStream_t stream) {
    if (n_in != 22 || out_size != T * DM || ws_size < WS_END) { fprintf(stderr, "kernel_launch: unexpected shapes (n_in %d out %d ws %zu)\n", n_in, out_size, ws_size); return; }
    static int grid = 0;
    if (grid == 0) {
        int dev = 0, cus = 0, per_cu = 0;
        if (hipFuncSetAttribute((const void*)mk_fwd, hipFuncAttributeMaxDynamicSharedMemorySize, LDS_BYTES) != hipSuccess) { fprintf(stderr, "kernel_launch: hipFuncSetAttribute failed\n"); grid = -1; return; }
        if (hipGetDevice(&dev) != hipSuccess || hipDeviceGetAttribute(&cus, hipDeviceAttributeMultiprocessorCount, dev) != hipSuccess) { fprintf(stderr, "kernel_launch: device query failed\n"); grid = -1; return; }
        if (hipOccupancyMaxActiveBlocksPerMultiprocessor(&per_cu, (const void*)mk_fwd, NTHR, LDS_BYTES) != hipSuccess || per_cu < 1) { fprintf(stderr, "kernel_launch: occupancy query says %d blocks per CU\n", per_cu); grid = -1; return; }
        grid = cus;
    }
    if (grid < 0) return;
    Args a{}; fill_args(a, d_in, d_out, d_ws); a.ph_lo = 0; a.ph_hi = NPH;
    void* args[] = {&a};
    const hipError_t e = hipLaunchCooperativeKernel((const void*)mk_fwd, dim3(grid), dim3(NTHR), args, LDS_BYTES, stream);
    if (e != hipSuccess) fprintf(stderr, "kernel_launch: cooperative launch failed: %s (grid %d)\n", hipGetErrorString(e), grid);
}
```

```cpp
#include <hip/hip_runtime.h>
#include <hip/hip_cooperative_groups.h>
#include <cstdio>
#include <cstdint>
#include <cmath>

constexpr int DM = 1024, NB = 4, SEQ = 8192, T = NB * SEQ;
constexpr int HD = 64, NQH = 8, NKVH = 2, AW = 512, KVW = 128, WINDOW = 128, BLK = 128;
constexpr int CW = 512, INC = 2304, DFF = 2816, MEML = 256, XH = 4, XHD = 256, MROWS = NB * MEML;
constexpr float RMS_EPS = 1e-5f;
constexpr float LOG2E = 1.4426950408889634f;
constexpr float QSCALE = 0.125f * LOG2E;
constexpr float XSCALE = 0.0625f * LOG2E;

typedef unsigned short bf16_t;
__host__ __device__ __forceinline__ unsigned f2bf(float f) { unsigned u = __builtin_bit_cast(unsigned, f); return (u + 0x7fffu + ((u >> 16) & 1u)) >> 16; }
__host__ __device__ __forceinline__ float bf2f(unsigned h) { return __builtin_bit_cast(float, (h & 0xffffu) << 16); }

constexpr size_t MiB = 1u << 20;
constexpr size_t WS_CTL = 0;
constexpr size_t WS_W1I = 1 * MiB, WS_W1O = 12 * MiB, WS_WMI = 18 * MiB, WS_WMO = 23 * MiB, WS_WXQ = 25 * MiB, WS_WXKV = 27 * MiB, WS_WXO = 31 * MiB, WS_W2I = 33 * MiB, WS_W2O = 44 * MiB;
constexpr size_t WS_ROPE = 50 * MiB;
constexpr size_t WS_SS = 58 * MiB;
constexpr size_t WS_SSMEM = 68 * MiB;
constexpr size_t WS_GMO = 68 * MiB + 512 * 1024;
constexpr size_t WS_MEMB = 69 * MiB;
constexpr size_t WS_KVM = 71 * MiB;
constexpr size_t WS_HB = 76 * MiB;
constexpr size_t WS_G = 140 * MiB;
constexpr size_t WS_Q = 140 * MiB, WS_K = 172 * MiB, WS_V = 180 * MiB, WS_GB = 188 * MiB, WS_Z = 220 * MiB, WS_MIXED = 252 * MiB;
constexpr size_t WS_XQ = 140 * MiB, WS_XO = 204 * MiB;
constexpr size_t WS_AQ = 316 * MiB;
constexpr size_t WS_SCA = 348 * MiB;
constexpr size_t WS_SW = 349 * MiB;
constexpr size_t WS_CMAX = 16384;
constexpr size_t WS_END = 350 * MiB;
constexpr size_t WS_TMP = 316 * MiB;
constexpr size_t WS_NEED = 508 * MiB;
__host__ __device__ __forceinline__ size_t ws_ss(int i) { return WS_SS + (size_t)i * 2 * MiB; }
namespace pg8 {
#define PG8_LAS __attribute__((address_space(3)))
typedef unsigned short bf16_t;
typedef short bf16x8 __attribute__((ext_vector_type(8)));
typedef float f32x4 __attribute__((ext_vector_type(4)));
typedef unsigned u32x4 __attribute__((ext_vector_type(4)));
constexpr int BM = 256, BK = 64, HALF = 128, HTB = HALF * BK * 2  , STAGE_BYTES = 8 * HTB, NXCD = 8, WGM = 8;

__host__ __device__ __forceinline__ int lds_byte(int r, int c) { const int st = (r >> 4) * 2 + (c >> 5), rr = r & 15, cc = c & 31, ob = rr * 64 + cc * 2; return st * 1024 + (ob ^ (((ob >> 9) & 1) << 5)); }
__host__ __device__ __forceinline__ void stage_rc(int b, int& R, int& C) { const int st = b / 1024, sb = b % 1024, swz = sb ^ (((sb >> 9) & 1) << 5); R = (st >> 1) * 16 + swz / 64; C = (st & 1) * 32 + (swz % 64) / 2; }
__host__ __device__ __forceinline__ int perm32(int rho) { const int n = rho >> 4, i = rho & 15; return 8 * (i >> 2) + 4 * n + (i & 3); }

struct Unit { int pm, pn; };
struct Gemm { const bf16_t* A; const bf16_t* Bt; int M, N, K; };

struct StaticOrder {
    int nM, nN, nwg, G, c;
    __host__ __device__ void init(int M, int N, int G_, int c_) { nM = M / BM; nN = N / BM; nwg = nM * nN; G = G_; c = c_; }
    __host__ __device__ bool next(int i, Unit& u) const {
        const long L = (long)i * G + c; if (L >= nwg) return false;
        int wgid = (int)L; { const int q = nwg / NXCD, r = nwg % NXCD, xcd = wgid % NXCD, off = wgid / NXCD; wgid = (xcd < r ? xcd * (q + 1) : r * (q + 1) + (xcd - r) * q) + off; }
        const int nig = WGM * nN, gid = wgid / nig, fm = gid * WGM, gsz = (nM - fm) < WGM ? (nM - fm) : WGM;
        u.pm = fm + ((wgid % nig) % gsz); u.pn = (wgid % nig) / gsz; return true;
    }
    __device__ __forceinline__ void a_ready(const Unit&) const {}
    __device__ __forceinline__ void done(const Unit&) const {}
};
typedef float f32x2c_t __attribute__((ext_vector_type(2))); typedef __bf16 bf16x2c_t __attribute__((ext_vector_type(2)));
__device__ __forceinline__ unsigned cvt_pk_bf16(float lo, float hi) { f32x2c_t v = {lo, hi}; bf16x2c_t b = __builtin_convertvector(v, bf16x2c_t); return __builtin_bit_cast(unsigned, b); }
typedef float f32x2 __attribute__((ext_vector_type(2)));

template <bool I8> __device__ __forceinline__ f32x4 mma16(bf16x8 b, bf16x8 a, f32x4 c) {
    if constexpr (I8) { typedef int i32x4 __attribute__((ext_vector_type(4)));
        return __builtin_bit_cast(f32x4, __builtin_amdgcn_mfma_i32_16x16x64_i8(__builtin_bit_cast(i32x4, b), __builtin_bit_cast(i32x4, a), __builtin_bit_cast(i32x4, c), 0, 0, 0)); }
    else return __builtin_amdgcn_mfma_f32_16x16x32_bf16(b, a, c, 0, 0, 0);
}
template <class Epi, class Sched, bool ALIGN_EPI = false, bool SP2 = false>
__device__ __forceinline__ void gemm_phase(PG8_LAS unsigned char* lds, const Gemm g, const Sched& S, const Epi& E) {
    const int tid = threadIdx.x, wid = __builtin_amdgcn_readfirstlane(tid >> 6), lane = tid & 63, wr = wid >> 2, wc = wid & 3, fr = lane & 15, fq = lane >> 4;
    const int K = g.K, nt = K / BK;
    unsigned voffA[2], voffB[2];
#pragma unroll
    for (int i = 0; i < 2; ++i) { int R, C; stage_rc(tid * 16 + i * 8192, R, C); const int Rb = Epi::PERM ? ((R & ~31) + perm32(R & 31)) : R;
        voffA[i] = (unsigned)(R * K + C) * 2u; voffB[i] = (unsigned)(Rb * K + C) * 2u; }
    const size_t kstep = (size_t)(BK * 2);
    const size_t hstep = (size_t)HALF * K * 2;
    const size_t tstep = 2 * hstep;
    const unsigned ldsw = (unsigned)wid * 1024u;
    const int aoff = lds_byte(wr * 64 + fr, fq * 8), boff = lds_byte(wc * 32 + fr, fq * 8);
#define PG8_SA(b, h) (((b) * 2 + (h)) * HTB)
#define PG8_SB(b, h) ((4 + (b) * 2 + (h)) * HTB)
#define PG8_STAGE(bufoff, gbase, voff) do { _Pragma("unroll") for (int _i = 0; _i < 2; ++_i) \
        __builtin_amdgcn_global_load_lds((const unsigned*)((const char*)(gbase) + (voff)[_i]), (PG8_LAS unsigned*)(lds + (bufoff) + ldsw + _i * 8192), 16, 0, 0); } while (0)
#define PG8_LDA(dst, b, h) do { _Pragma("unroll") for (int m = 0; m < 4; ++m) _Pragma("unroll") for (int k = 0; k < 2; ++k) dst[m][k] = *(const PG8_LAS bf16x8*)(lds + PG8_SA(b, h) + aoff + m * 2048 + k * 1024); } while (0)
#define PG8_LDB(dst, b, h) do { _Pragma("unroll") for (int n = 0; n < 2; ++n) _Pragma("unroll") for (int k = 0; k < 2; ++k) dst[n][k] = *(const PG8_LAS bf16x8*)(lds + PG8_SB(b, h) + boff + n * 2048 + k * 1024); } while (0)
#define PG8_MMA(ai, bj, At, Bt) do { __builtin_amdgcn_s_setprio(1); _Pragma("unroll") for (int m = 0; m < 4; ++m) _Pragma("unroll") for (int n = 0; n < 2; ++n) _Pragma("unroll") for (int k = 0; k < 2; ++k) \
        acc[ai][bj][m][n] = mma16<Epi::I8>(Bt[n][k], At[m][k], acc[ai][bj][m][n]); __builtin_amdgcn_s_setprio(0); } while (0)
#define PG8_WAIT_V(n) asm volatile("s_waitcnt vmcnt(" #n ")" ::: "memory")
#define PG8_WAIT_L(n) asm volatile("s_waitcnt lgkmcnt(" #n ")" ::: "memory")
#define PG8_BAR __builtin_amdgcn_s_barrier()
#define PG8_SCHED __builtin_amdgcn_sched_barrier(0)
    Unit cur, nxt; int ui = 0;
    if (!S.next(0, cur)) return;
    f32x4 acc[2][2][4][2];
#pragma unroll
    for (int a = 0; a < 2; ++a)
#pragma unroll
        for (int b = 0; b < 2; ++b)
#pragma unroll
            for (int m = 0; m < 4; ++m)
#pragma unroll
                for (int n = 0; n < 2; ++n) acc[a][b][m][n] = (f32x4){0.f, 0.f, 0.f, 0.f};
    bf16x8 At[4][2], B0[2][2], B1[2][2];
    const char* cA = (const char*)g.A + (size_t)cur.pm * tstep; const char* cB = (const char*)g.Bt + (size_t)cur.pn * tstep;
    S.a_ready(cur);
    if constexpr (SP2) {
        PG8_STAGE(PG8_SB(0, 0), cB, voffB); PG8_STAGE(PG8_SB(0, 1), cB + hstep, voffB); PG8_STAGE(PG8_SA(0, 0), cA, voffA); PG8_STAGE(PG8_SA(0, 1), cA + hstep, voffA);
        if (wr == 1) PG8_BAR;
        PG8_WAIT_V(2); PG8_BAR;
        PG8_STAGE(PG8_SB(1, 0), cB + kstep, voffB); PG8_STAGE(PG8_SA(1, 0), cA + kstep, voffA); PG8_STAGE(PG8_SB(1, 1), cB + hstep + kstep, voffB);
        PG8_WAIT_V(6); PG8_BAR;
    } else {
        PG8_STAGE(PG8_SB(0, 0), cB, voffB); PG8_STAGE(PG8_SA(0, 0), cA, voffA); PG8_STAGE(PG8_SB(0, 1), cB + hstep, voffB); PG8_STAGE(PG8_SA(0, 1), cA + hstep, voffA);
        if (wr == 1) PG8_BAR;
        PG8_WAIT_V(4); PG8_BAR;
        PG8_STAGE(PG8_SB(1, 0), cB + kstep, voffB); PG8_STAGE(PG8_SA(1, 0), cA + kstep, voffA); PG8_STAGE(PG8_SB(1, 1), cB + hstep + kstep, voffB);
        PG8_WAIT_V(6); PG8_BAR;
    }
    for (;;) {
        const bool has_next = S.next(ui + 1, nxt);
        const char* nA = has_next ? (const char*)g.A + (size_t)nxt.pm * tstep : cA; const char* nB = has_next ? (const char*)g.Bt + (size_t)nxt.pn * tstep : cB;
        for (int t = 0; t < nt; t += 2) {
            const bool last = (t == nt - 2);
            const char* a1 = cA + (size_t)(t + 1) * kstep;
            const char* a2 = last ? nA : cA + (size_t)(t + 2) * kstep; const char* b2 = last ? nB : cB + (size_t)(t + 2) * kstep;
            const char* a3 = a2 + kstep; const char* b3 = b2 + kstep;
            if (last && has_next) S.a_ready(nxt);
            if constexpr (SP2) {
            PG8_LDB(B0, 0, 0); PG8_LDB(B1, 0, 1); PG8_SCHED; PG8_LDA(At, 0, 0); PG8_STAGE(PG8_SA(1, 1), a1 + hstep, voffA);
            PG8_WAIT_V(8); PG8_WAIT_L(0); PG8_BAR; PG8_MMA(0, 0, At, B0); PG8_MMA(0, 1, At, B1); PG8_BAR; PG8_SCHED;
            PG8_LDA(At, 0, 1); PG8_STAGE(PG8_SB(0, 0), b2, voffB); PG8_STAGE(PG8_SB(0, 1), b2 + hstep, voffB); PG8_STAGE(PG8_SA(0, 0), a2, voffA);
            PG8_WAIT_V(8); PG8_WAIT_L(0); PG8_BAR; PG8_MMA(1, 0, At, B0); PG8_MMA(1, 1, At, B1); PG8_BAR; PG8_SCHED;
            PG8_LDB(B0, 1, 0); PG8_LDB(B1, 1, 1); PG8_SCHED; PG8_LDA(At, 1, 0); PG8_STAGE(PG8_SA(0, 1), a2 + hstep, voffA);
            PG8_WAIT_V(8); PG8_WAIT_L(0); PG8_BAR; PG8_MMA(0, 0, At, B0); PG8_MMA(0, 1, At, B1); PG8_BAR; PG8_SCHED;
            PG8_LDA(At, 1, 1); PG8_STAGE(PG8_SB(1, 0), b3, voffB); PG8_STAGE(PG8_SB(1, 1), b3 + hstep, voffB); PG8_STAGE(PG8_SA(1, 0), a3, voffA);
            PG8_WAIT_V(8); PG8_WAIT_L(0); PG8_BAR; PG8_MMA(1, 0, At, B0); PG8_MMA(1, 1, At, B1); PG8_BAR; PG8_SCHED;
            } else {
            PG8_LDB(B0, 0, 0); PG8_SCHED; PG8_LDA(At, 0, 0); PG8_STAGE(PG8_SA(1, 1), a1 + hstep, voffA);
            PG8_WAIT_L(8); PG8_BAR; PG8_WAIT_L(0); PG8_MMA(0, 0, At, B0); PG8_BAR; PG8_SCHED;
            PG8_LDB(B1, 0, 1); PG8_STAGE(PG8_SB(0, 0), b2, voffB);
            PG8_BAR; PG8_WAIT_L(0); PG8_MMA(0, 1, At, B1); PG8_BAR;
            PG8_LDA(At, 0, 1); PG8_STAGE(PG8_SA(0, 0), a2, voffA);
            PG8_BAR; PG8_WAIT_L(0); PG8_MMA(1, 0, At, B0); PG8_BAR; PG8_SCHED;
            PG8_STAGE(PG8_SB(0, 1), b2 + hstep, voffB);
            PG8_WAIT_V(6); PG8_BAR; PG8_MMA(1, 1, At, B1); PG8_BAR;
            PG8_LDB(B0, 1, 0); PG8_SCHED; PG8_LDA(At, 1, 0); PG8_STAGE(PG8_SA(0, 1), a2 + hstep, voffA);
            PG8_WAIT_L(8); PG8_BAR; PG8_WAIT_L(0); PG8_MMA(0, 0, At, B0); PG8_BAR; PG8_SCHED;
            PG8_LDB(B1, 1, 1); PG8_STAGE(PG8_SB(1, 0), b3, voffB);
            PG8_BAR; PG8_WAIT_L(0); PG8_MMA(0, 1, At, B1); PG8_BAR;
            PG8_LDA(At, 1, 1); PG8_STAGE(PG8_SA(1, 0), a3, voffA);
            PG8_BAR; PG8_WAIT_L(0); PG8_MMA(1, 0, At, B0); PG8_BAR; PG8_SCHED;
            PG8_STAGE(PG8_SB(1, 1), b3 + hstep, voffB);
            PG8_WAIT_V(6); PG8_BAR; PG8_MMA(1, 1, At, B1); PG8_BAR;
            }
        }
        if constexpr (ALIGN_EPI) { if (wr == 0) PG8_BAR; }
        if constexpr (!Epi::AFTER_DRAIN) { E(acc, cur, wr, wc, fr, fq);
#ifdef EPI_TWICE
            if constexpr (Epi::IDEM) { asm volatile("" ::: "memory"); E(acc, cur, wr, wc, fr, fq); }
#endif
            S.done(cur); }
        if (!has_next) break;
#pragma unroll
        for (int a = 0; a < 2; ++a)
#pragma unroll
            for (int b = 0; b < 2; ++b)
#pragma unroll
                for (int m = 0; m < 4; ++m)
#pragma unroll
                    for (int n = 0; n < 2; ++n) acc[a][b][m][n] = (f32x4){0.f, 0.f, 0.f, 0.f};
        cur = nxt; cA = nA; cB = nB; ++ui;
        if constexpr (ALIGN_EPI) { if (wr == 1) PG8_BAR; }
    }
    PG8_WAIT_V(0);
    if constexpr (!ALIGN_EPI) { if (wr == 0) PG8_BAR; }
    PG8_BAR;
    if constexpr (Epi::AFTER_DRAIN) { E.fused(acc, cur, wr, wc, fr, fq, lds, wid, lane); S.done(cur); }
#undef PG8_SA
#undef PG8_SB
#undef PG8_STAGE
#undef PG8_LDA
#undef PG8_LDB
#undef PG8_MMA
#undef PG8_WAIT_V
#undef PG8_WAIT_L
#undef PG8_BAR
#undef PG8_SCHED
}

__device__ __forceinline__ float row_rstd(const float* ssp, int row, int fq) {
    const f32x4 p = *(const f32x4*)(ssp + (size_t)row * 16 + 4 * fq);
    float s = (p[0] + p[1]) + (p[2] + p[3]);
    s += __shfl_xor(s, 16); s += __shfl_xor(s, 32);
    return __builtin_amdgcn_rsqf(s * (1.0f / 1024.0f) + 1e-5f);
}
__device__ __forceinline__ u32x4 pack8(const float (&o)[8]) { u32x4 w; w.x = cvt_pk_bf16(o[0], o[1]); w.y = cvt_pk_bf16(o[2], o[3]); w.z = cvt_pk_bf16(o[4], o[5]); w.w = cvt_pk_bf16(o[6], o[7]); return w; }

struct EpiSwiGLU {
    static constexpr bool PERM = true, AFTER_DRAIN = false, IDEM = true, I8 = false;
    bf16_t* G; const float* ssp;
    __device__ __forceinline__ void operator()(const f32x4 (&acc)[2][2][4][2], const Unit& u, int wr, int wc, int fr, int fq) const {
        const int row0 = u.pm * BM + wr * 64 + fr, col0 = u.pn * HALF + wc * 32 + 8 * fq;
#pragma unroll
        for (int ai = 0; ai < 2; ++ai)
#pragma unroll
            for (int m = 0; m < 4; ++m) {
                const int row = row0 + ai * HALF + m * 16; const float r = row_rstd(ssp, row, fq); float o[8];
#pragma unroll
                for (int n = 0; n < 2; ++n)
#pragma unroll
                    for (int e = 0; e < 4; ++e) { const float g = acc[ai][0][m][n][e] * r, up = acc[ai][1][m][n][e] * r;
                        o[4 * n + e] = g * __builtin_amdgcn_rcpf(1.0f + __builtin_amdgcn_exp2f(g * -1.4426950408889634f)) * up; }
                *(u32x4*)(G + (size_t)row * 2816 + col0) = pack8(o);
            }
    }
};
struct EpiSwiGLU8 {
    static constexpr bool PERM = true, AFTER_DRAIN = false, IDEM = true, I8 = true;
    bf16_t* G; const float* sca; const float* sw;
    __device__ __forceinline__ void operator()(const f32x4 (&acc)[2][2][4][2], const Unit& u, int wr, int wc, int fr, int fq) const {
        const int row0 = u.pm * BM + wr * 64 + fr, col0 = u.pn * HALF + wc * 32 + 8 * fq;
        float sg[8], su[8];
        { const float* sp = sw + u.pn * BM + wc * 32 + 8 * fq; const f32x4 g0 = *(const f32x4*)sp, g1 = *(const f32x4*)(sp + 4), u0 = *(const f32x4*)(sp + HALF), u1 = *(const f32x4*)(sp + HALF + 4);
#pragma unroll
          for (int e = 0; e < 4; ++e) { sg[e] = g0[e]; sg[4 + e] = g1[e]; su[e] = u0[e]; su[4 + e] = u1[e]; } }
#pragma unroll
        for (int ai = 0; ai < 2; ++ai)
#pragma unroll
            for (int m = 0; m < 4; ++m) {
                const int row = row0 + ai * HALF + m * 16; const float r = sca[row]; float o[8];
#pragma unroll
                for (int n = 0; n < 2; ++n) { typedef int i32x4 __attribute__((ext_vector_type(4)));
                    const i32x4 gi = __builtin_bit_cast(i32x4, acc[ai][0][m][n]), ui = __builtin_bit_cast(i32x4, acc[ai][1][m][n]);
#pragma unroll
                    for (int e = 0; e < 4; ++e) { const float g = (float)gi[e] * (r * sg[4 * n + e]), up = (float)ui[e] * (r * su[4 * n + e]);
                        o[4 * n + e] = g * __builtin_amdgcn_rcpf(1.0f + __builtin_amdgcn_exp2f(g * -1.4426950408889634f)) * up; } }
                *(u32x4*)(G + (size_t)row * 2816 + col0) = pack8(o);
            }
    }
};
template <bool F32IN> struct EpiResid {
    static constexpr bool PERM = true, AFTER_DRAIN = false, IDEM = F32IN, I8 = false;
    const float* hin32; bf16_t* hb; float* ssp; float w;
    __device__ __forceinline__ void operator()(const f32x4 (&acc)[2][2][4][2], const Unit& u, int wr, int wc, int fr, int fq) const {
        const int row0 = u.pm * BM + wr * 64 + fr, col0 = u.pn * BM + wc * 32 + 8 * fq;
#pragma unroll
        for (int ai = 0; ai < 2; ++ai)
#pragma unroll
            for (int m = 0; m < 4; ++m) {
                const int row = row0 + ai * HALF + m * 16; float ss = 0.f;
#pragma unroll
                for (int bj = 0; bj < 2; ++bj) { const size_t off = (size_t)row * 1024 + col0 + bj * HALF;
                    f32x4 a0, a1;
                    if (F32IN) { a0 = *(const f32x4*)(hin32 + off); a1 = *(const f32x4*)(hin32 + off + 4); }
                    else { const u32x4 hv = *(const u32x4*)(hb + off);
                        a0 = (f32x4){__builtin_bit_cast(float, hv.x << 16), __builtin_bit_cast(float, hv.x & 0xffff0000u), __builtin_bit_cast(float, hv.y << 16), __builtin_bit_cast(float, hv.y & 0xffff0000u)};
                        a1 = (f32x4){__builtin_bit_cast(float, hv.z << 16), __builtin_bit_cast(float, hv.z & 0xffff0000u), __builtin_bit_cast(float, hv.w << 16), __builtin_bit_cast(float, hv.w & 0xffff0000u)}; }
                    const f32x4 v0 = a0 + acc[ai][bj][m][0] * w, v1 = a1 + acc[ai][bj][m][1] * w;
                    u32x4 pk; pk.x = cvt_pk_bf16(v0[0], v0[1]); pk.y = cvt_pk_bf16(v0[2], v0[3]); pk.z = cvt_pk_bf16(v1[0], v1[1]); pk.w = cvt_pk_bf16(v1[2], v1[3]);
                    *(u32x4*)(hb + off) = pk;
                    ss += (v0[0] * v0[0] + v0[1] * v0[1]) + (v0[2] * v0[2] + v0[3] * v0[3]) + (v1[0] * v1[0] + v1[1] * v1[1]) + (v1[2] * v1[2] + v1[3] * v1[3]); }
                ss += __shfl_xor(ss, 16); ss += __shfl_xor(ss, 32);
                if (fq == 0) ssp[(size_t)row * 16 + u.pn * 4 + wc] = ss;
                if (m & 1) asm volatile("" ::: "memory");
            }
    }
};
struct EpiMixIn {
    static constexpr bool PERM = true, AFTER_DRAIN = false, IDEM = true, I8 = false;
    const float* ssp; const float* rope; bf16_t* Q; bf16_t* K; bf16_t* V; bf16_t* GB; bf16_t* Z;
    __device__ __forceinline__ void operator()(const f32x4 (&acc)[2][2][4][2], const Unit& u, int wr, int wc, int fr, int fq) const {
        const int row0 = u.pm * BM + wr * 64 + fr, pn = u.pn;
#pragma unroll
        for (int ai = 0; ai < 2; ++ai)
#pragma unroll
            for (int m = 0; m < 4; ++m) {
                const int row = row0 + ai * HALF + m * 16; const float r = row_rstd(ssp, row, fq);
                if (pn < 3) {
                    float t1[8], t2[8];
#pragma unroll
                    for (int n = 0; n < 2; ++n)
#pragma unroll
                        for (int e = 0; e < 4; ++e) { t1[4 * n + e] = acc[ai][0][m][n][e] * r; t2[4 * n + e] = acc[ai][1][m][n][e] * r; }
                    if (pn < 2 || wc < 2) {
                        const f32x4* rp = (const f32x4*)(rope + ((size_t)row * 32 + 8 * fq) * 2);
#pragma unroll
                        for (int i = 0; i < 4; ++i) { const f32x4 cs = rp[i];
                            { const float a = t1[2 * i], b = t2[2 * i]; t1[2 * i] = a * cs[0] - b * cs[1]; t2[2 * i] = b * cs[0] + a * cs[1]; }
                            { const float a = t1[2 * i + 1], b = t2[2 * i + 1]; t1[2 * i + 1] = a * cs[2] - b * cs[3]; t2[2 * i + 1] = b * cs[2] + a * cs[3]; } }
                    }
                    bf16_t* dst; float sc = 1.0f;
                    if (pn < 2) { dst = Q + (size_t)row * 512 + (4 * pn + wc) * 64 + 8 * fq; sc = 0.125f * 1.4426950408889634f; }
                    else if (wc < 2) dst = K + (size_t)row * 128 + wc * 64 + 8 * fq;
                    else dst = V + (size_t)row * 128 + (wc - 2) * 64 + 8 * fq;
#pragma unroll
                    for (int i = 0; i < 8; ++i) { t1[i] *= sc; t2[i] *= sc; }
                    *(u32x4*)dst = pack8(t1); *(u32x4*)(dst + 32) = pack8(t2);
                } else if (pn < 5) {
#pragma unroll
                    for (int bj = 0; bj < 2; ++bj) { float o[8];
#pragma unroll
                        for (int n = 0; n < 2; ++n)
#pragma unroll
                            for (int e = 0; e < 4; ++e) o[4 * n + e] = acc[ai][bj][m][n][e] * r;
                        *(u32x4*)(GB + (size_t)row * 512 + (pn - 3) * 256 + bj * HALF + wc * 32 + 8 * fq) = pack8(o); }
                } else {
                    float o[8];
#pragma unroll
                    for (int n = 0; n < 2; ++n)
#pragma unroll
                        for (int e = 0; e < 4; ++e) o[4 * n + e] = (acc[ai][0][m][n][e] * r) * (acc[ai][1][m][n][e] * r);
                    *(u32x4*)(Z + (size_t)row * 512 + (pn - 5) * HALF + wc * 32 + 8 * fq) = pack8(o);
                }
            }
    }
};
struct EpiScale {
    static constexpr bool PERM = true, AFTER_DRAIN = false, IDEM = true, I8 = false;
    bf16_t* O; int ldo; const float* ssp; float scale;
    __device__ __forceinline__ void operator()(const f32x4 (&acc)[2][2][4][2], const Unit& u, int wr, int wc, int fr, int fq) const {
        const int row0 = u.pm * BM + wr * 64 + fr, col0 = u.pn * BM + wc * 32 + 8 * fq;
#pragma unroll
        for (int ai = 0; ai < 2; ++ai)
#pragma unroll
            for (int m = 0; m < 4; ++m) {
                const int row = row0 + ai * HALF + m * 16; const float r = row_rstd(ssp, row, fq) * scale;
#pragma unroll
                for (int bj = 0; bj < 2; ++bj) { float o[8];
#pragma unroll
                    for (int n = 0; n < 2; ++n)
#pragma unroll
                        for (int e = 0; e < 4; ++e) o[4 * n + e] = acc[ai][bj][m][n][e] * r;
                    *(u32x4*)(O + (size_t)row * ldo + col0 + bj * HALF) = pack8(o); }
            }
    }
};
struct ListOrder {
    int idx0, cnt, nN;
    __device__ bool next(int i, Unit& u) const { if (i >= cnt) return false; const int id = idx0 + i; u.pm = id / nN; u.pn = id % nN; return true; }
    __device__ __forceinline__ void a_ready(const Unit&) const {}
    __device__ __forceinline__ void done(const Unit&) const {}
};
}
namespace cg = cooperative_groups;
#define LAS __attribute__((address_space(3)))
#define GAS __attribute__((address_space(1)))
typedef unsigned v4u __attribute__((ext_vector_type(4)));
typedef unsigned v2u __attribute__((ext_vector_type(2)));
typedef float f32x4 __attribute__((ext_vector_type(4)));
typedef float f32x16 __attribute__((ext_vector_type(16)));
typedef short bf16x8 __attribute__((ext_vector_type(8)));
typedef short s16x4 __attribute__((ext_vector_type(4)));
#define LDS_WAIT() asm volatile("s_waitcnt lgkmcnt(0)" ::: "memory")
constexpr int NWAVES = 8, NTHR = 512;
constexpr int RING_BYTES = 131072, XTRA_OFF = RING_BYTES, LDS_BYTES = 147456;
constexpr int NPH = 14;

struct Args {
    const float* x; const float* mem; const int* pos; const float* g_ffn1; const float* w_ffn1_in; const float* w_ffn1_out; const float* g_mix; const float* w_mix_in;
    const float* sinks; const float* conv_w; const float* g_attn_out; const float* g_conv_out; const float* w_mix_out; const float* g_mem; const float* g_xattn;
    const float* w_xq; const float* w_xkv; const float* w_xo; const float* g_ffn2; const float* w_ffn2_in; const float* w_ffn2_out; const float* g_final;
    float* out; unsigned char* ws; int ph_lo, ph_hi;
};
__device__ __forceinline__ unsigned pk2(float lo, float hi) { return f2bf(lo) | (f2bf(hi) << 16); }
typedef float f32x2_t __attribute__((ext_vector_type(2))); typedef __bf16 bf16x2_t __attribute__((ext_vector_type(2)));
__device__ __forceinline__ unsigned cvtpk(float lo, float hi) { f32x2_t v = {lo, hi}; bf16x2_t b = __builtin_convertvector(v, bf16x2_t); return __builtin_bit_cast(unsigned, b); }
__device__ __forceinline__ float wave_sum(float v) {
#pragma unroll
    for (int o = 1; o < 64; o <<= 1) v += __shfl_xor(v, o);
    return v;
}
__device__ __forceinline__ int rowmap(int mode, int n0) {
    if (mode == 1) { const int bj = n0 >= DFF ? 1 : 0, jj = n0 - bj * DFF; return 256 * (jj >> 7) + 128 * bj + (jj & 127); }
    if (mode == 2) {
        if (n0 < 512) { const int hd = n0 >> 6, bj = (n0 >> 5) & 1; return 256 * (hd >> 2) + 128 * bj + 32 * (hd & 3); }
        if (n0 < 768) { const int c = n0 - 512, sl = c >> 6, bj = (c >> 5) & 1; return 512 + 128 * bj + 32 * sl; }
        if (n0 < 1280) return n0;
        const int c = n0 - 1280, bj = c >= 512 ? 1 : 0, cc = c - 512 * bj; return 1280 + 256 * (cc >> 7) + 128 * bj + (cc & 127);
    }
    return n0;
}
__device__ __forceinline__ void p0_transpose_item(const float* W, const float* gain, const float* gain2, int K, int N, bf16_t* WT, int mode, LAS float* scr, int item, int lane) {
    const int nblk = N / 32, kb = item / nblk, nb = item % nblk, k0 = 64 * kb, n0 = 32 * nb;
#pragma unroll 8
    for (int i = 0; i < 32; ++i) { const int kk = 2 * i + (lane >> 5), k = k0 + kk; float g = 1.0f; if (gain) g = (gain2 && k >= 512) ? gain2[k - 512] : gain[k];
        scr[kk * 33 + (lane & 31)] = W[(size_t)k * N + n0 + (lane & 31)] * g; }
    LDS_WAIT(); asm volatile("" ::: "memory");
    const int c = lane & 7, r0 = rowmap(mode, n0);
#pragma unroll
    for (int j = 0; j < 4; ++j) { const int n = (lane >> 3) + 8 * j; const LAS float* s = scr + (8 * c) * 33 + n;
        v4u o; o.x = pk2(s[0 * 33], s[1 * 33]); o.y = pk2(s[2 * 33], s[3 * 33]); o.z = pk2(s[4 * 33], s[5 * 33]); o.w = pk2(s[6 * 33], s[7 * 33]);
        *(v4u*)(WT + (size_t)(r0 + n) * K + k0 + 8 * c) = o; }
    LDS_WAIT(); asm volatile("" ::: "memory");
}
__device__ __forceinline__ void stats_row(const float* xrow, bf16_t* orow, float* ssrow, int lane) {
    const f32x4* xr = (const f32x4*)xrow + lane; f32x4 v[4]; float s = 0.f;
#pragma unroll
    for (int j = 0; j < 4; ++j) { v[j] = xr[64 * j]; s += (v[j].x * v[j].x + v[j].y * v[j].y) + (v[j].z * v[j].z + v[j].w * v[j].w); }
    s = wave_sum(s);
    v2u* o8 = (v2u*)orow + lane;
#pragma unroll
    for (int j = 0; j < 4; ++j) { v2u w; w.x = cvtpk(v[j].x, v[j].y); w.y = cvtpk(v[j].z, v[j].w); o8[64 * j] = w; }
    if (lane < 16) ssrow[lane] = lane == 0 ? s : 0.f;
}
__device__ __forceinline__ void quant_row_f32(const float* xrow, unsigned char* qrow, float* sca, int lane) {
    const f32x4* xr = (const f32x4*)xrow + lane; f32x4 v[4]; float s = 0.f, mx = 0.f;
#pragma unroll
    for (int j = 0; j < 4; ++j) { v[j] = xr[64 * j]; s += (v[j].x * v[j].x + v[j].y * v[j].y) + (v[j].z * v[j].z + v[j].w * v[j].w);
        mx = fmaxf(fmaxf(mx, fmaxf(fabsf(v[j].x), fabsf(v[j].y))), fmaxf(fabsf(v[j].z), fabsf(v[j].w))); }
    s = wave_sum(s);
#pragma unroll
    for (int o = 1; o < 64; o <<= 1) mx = fmaxf(mx, __shfl_xor(mx, o));
    const float inv = mx > 0.f ? 127.0f / mx : 0.f;
    unsigned* q4 = (unsigned*)qrow + lane;
#pragma unroll
    for (int j = 0; j < 4; ++j) { const int q0 = (int)rintf(v[j].x * inv), q1 = (int)rintf(v[j].y * inv), q2 = (int)rintf(v[j].z * inv), q3 = (int)rintf(v[j].w * inv);
        q4[64 * j] = (unsigned)(q0 & 0xff) | ((unsigned)(q1 & 0xff) << 8) | ((unsigned)(q2 & 0xff) << 16) | ((unsigned)(q3 & 0xff) << 24); }
    if (lane == 0) *sca = (1.0f / sqrtf(s * (1.0f / DM) + RMS_EPS)) * mx * (1.0f / 127.0f);
}
__device__ __forceinline__ void quant_row_bf16(const bf16_t* hrow, unsigned char* qrow, float* sca, int lane) {
    float v[16]; float s = 0.f, mx = 0.f;
#pragma unroll
    for (int j = 0; j < 2; ++j) { const v4u hv = *(const v4u*)(hrow + 512 * j + 8 * lane);
#pragma unroll
        for (int e = 0; e < 4; ++e) { v[8 * j + 2 * e] = bf2f(hv[e]); v[8 * j + 2 * e + 1] = bf2f(hv[e] >> 16); } }
#pragma unroll
    for (int i = 0; i < 16; ++i) { s += v[i] * v[i]; mx = fmaxf(mx, fabsf(v[i])); }
    s = wave_sum(s);
#pragma unroll
    for (int o = 1; o < 64; o <<= 1) mx = fmaxf(mx, __shfl_xor(mx, o));
    const float inv = mx > 0.f ? 127.0f / mx : 0.f;
#pragma unroll
    for (int j = 0; j < 2; ++j) { v2u w;
#pragma unroll
        for (int h2 = 0; h2 < 2; ++h2) { unsigned pk = 0u;
#pragma unroll
            for (int e = 0; e < 4; ++e) pk |= ((unsigned)((int)rintf(v[8 * j + 4 * h2 + e] * inv) & 0xff)) << (8 * e);
            w[h2] = pk; }
        *(v2u*)(qrow + 512 * j + 8 * lane) = w; }
    if (lane == 0) *sca = (1.0f / sqrtf(s * (1.0f / DM) + RMS_EPS)) * mx * (1.0f / 127.0f);
}
__device__ __forceinline__ void p0_absmax_item(const float* W, const float* gain, int N, unsigned* cmax, int item, int lane) {
    const int nblk = N / 256, kb = item / nblk, nb = item % nblk, k0 = 64 * kb, n0 = 256 * nb + 4 * lane;
    f32x4 m = (f32x4){0.f, 0.f, 0.f, 0.f};
#pragma unroll 8
    for (int i = 0; i < 64; ++i) { const f32x4 v = *(const f32x4*)(W + (size_t)(k0 + i) * N + n0); const float g = gain[k0 + i];
        m.x = fmaxf(m.x, fabsf(v.x * g)); m.y = fmaxf(m.y, fabsf(v.y * g)); m.z = fmaxf(m.z, fabsf(v.z * g)); m.w = fmaxf(m.w, fabsf(v.w * g)); }
    atomicMax(cmax + n0, __float_as_uint(m.x)); atomicMax(cmax + n0 + 1, __float_as_uint(m.y)); atomicMax(cmax + n0 + 2, __float_as_uint(m.z)); atomicMax(cmax + n0 + 3, __float_as_uint(m.w));
}
__device__ __forceinline__ void p0_quant_item(const float* W, const float* gain, int N, unsigned char* WQ, const unsigned* cmax, float* sw, int mode, LAS float* scr, int item, int lane) {
    const int nblk = N / 32, kb = item / nblk, nb = item % nblk, k0 = 64 * kb, n0 = 32 * nb;
#pragma unroll 8
    for (int i = 0; i < 32; ++i) { const int kk = 2 * i + (lane >> 5), k = k0 + kk;
        scr[kk * 33 + (lane & 31)] = W[(size_t)k * N + n0 + (lane & 31)] * gain[k]; }
    LDS_WAIT(); asm volatile("" ::: "memory");
    const int c = lane & 3, r0 = rowmap(mode, n0);
#pragma unroll
    for (int j = 0; j < 2; ++j) { const int n = (lane >> 2) + 16 * j; const LAS float* s = scr + (16 * c) * 33 + n;
        const float cm = __uint_as_float(cmax[n0 + n]); const float inv = cm > 0.f ? 127.0f / cm : 0.f;
        v4u o;
#pragma unroll
        for (int w4 = 0; w4 < 4; ++w4) { unsigned pk = 0u;
#pragma unroll
            for (int e = 0; e < 4; ++e) pk |= ((unsigned)((int)rintf(s[(4 * w4 + e) * 33] * inv) & 0xff)) << (8 * e);
            o[w4] = pk; }
        *(v4u*)(WQ + (size_t)(r0 + n) * DM + k0 + 16 * c) = o;
        if (kb == 0 && c == 0) sw[r0 + n] = cm * (1.0f / 127.0f); }
    LDS_WAIT(); asm volatile("" ::: "memory");
}
__device__ __forceinline__ void phase_prep(const Args& a, LAS unsigned char* lds, int G, int vcu) {
    const int tid = threadIdx.x, lane = tid & 63, wave = __builtin_amdgcn_readfirstlane(tid >> 6);
    LAS float* scr = (LAS float*)(lds + wave * 16384);
    const int gw = vcu * NWAVES + wave, NGW = G * NWAVES;
    unsigned char* ws = a.ws;
    { constexpr int I_AM = (DM / 64) * (2 * DFF / 256); unsigned* cm = (unsigned*)(ws + WS_CMAX);
      for (int it = gw; it < 2 * I_AM; it += NGW) { if (it < I_AM) p0_absmax_item(a.w_ffn1_in, a.g_ffn1, 2 * DFF, cm, it, lane); else p0_absmax_item(a.w_ffn2_in, a.g_ffn2, 2 * DFF, cm + 2 * DFF, it - I_AM, lane); } }
    constexpr int I_FO = (DFF / 64) * (DM / 32), I_MI = (DM / 64) * (INC / 32), I_SQ = (DM / 64) * (DM / 32), I_KV = (DM / 64) * (2 * DM / 32);
    constexpr int NITEMS = 2 * I_FO + I_MI + 3 * I_SQ + I_KV;
    for (int it = gw; it < NITEMS; it += NGW) {
        int r = it;
        if (r < I_FO) { p0_transpose_item(a.w_ffn1_out, nullptr, nullptr, DFF, DM, (bf16_t*)(ws + WS_W1O), 0, scr, r, lane); continue; } r -= I_FO;
        if (r < I_FO) { p0_transpose_item(a.w_ffn2_out, nullptr, nullptr, DFF, DM, (bf16_t*)(ws + WS_W2O), 0, scr, r, lane); continue; } r -= I_FO;
        if (r < I_MI) { p0_transpose_item(a.w_mix_in, a.g_mix, nullptr, DM, INC, (bf16_t*)(ws + WS_WMI), 2, scr, r, lane); continue; } r -= I_MI;
        if (r < I_SQ) { p0_transpose_item(a.w_mix_out, a.g_attn_out, a.g_conv_out, DM, DM, (bf16_t*)(ws + WS_WMO), 0, scr, r, lane); continue; } r -= I_SQ;
        if (r < I_SQ) { p0_transpose_item(a.w_xq, a.g_xattn, nullptr, DM, DM, (bf16_t*)(ws + WS_WXQ), 0, scr, r, lane); continue; } r -= I_SQ;
        if (r < I_SQ) { p0_transpose_item(a.w_xo, nullptr, nullptr, DM, DM, (bf16_t*)(ws + WS_WXO), 0, scr, r, lane); continue; } r -= I_SQ;
        p0_transpose_item(a.w_xkv, a.g_mem, nullptr, DM, 2 * DM, (bf16_t*)(ws + WS_WXKV), 0, scr, r, lane);
    }
    for (int m = gw; m < T + MROWS; m += NGW) {
        if (m < T) quant_row_f32(a.x + (size_t)m * DM, ws + WS_AQ + (size_t)m * DM, (float*)(ws + WS_SCA) + m, lane);
        else { const int r = m - T; stats_row(a.mem + (size_t)r * DM, (bf16_t*)(ws + WS_MEMB) + (size_t)r * DM, (float*)(ws + WS_SSMEM) + (size_t)r * 16, lane); }
    }
    float* rope = (float*)(ws + WS_ROPE);
    for (int i = (vcu * NTHR + tid); i < T * 32; i += G * NTHR) {
        const int row = i >> 5, d = i & 31;
        const double invf = exp2(-(double)d * (13.287712379549449 / 32.0));
        const double ang = (double)a.pos[row] * invf;
        const double kq = rint(ang * 0.15915494309189535); const double y = fma(-kq, 6.283185307179586, ang) - kq * 2.4492935982947064e-16;
        const float yf = (float)y;
        *(float2*)(rope + (size_t)i * 2) = make_float2(cosf(yf), sinf(yf));
    }
}
__device__ __forceinline__ void phase_prep_b(const Args& a, LAS unsigned char* lds, int G, int vcu) {
    const int tid = threadIdx.x, lane = tid & 63, wave = __builtin_amdgcn_readfirstlane(tid >> 6);
    LAS float* scr = (LAS float*)(lds + wave * 16384);
    const int gw = vcu * NWAVES + wave, NGW = G * NWAVES; unsigned char* ws = a.ws;
    constexpr int I_FI = (DM / 64) * (2 * DFF / 32); const unsigned* cm = (const unsigned*)(ws + WS_CMAX); float* sw = (float*)(ws + WS_SW);
    for (int it = gw; it < 2 * I_FI; it += NGW) {
        if (it < I_FI) p0_quant_item(a.w_ffn1_in, a.g_ffn1, 2 * DFF, ws + WS_W1I, cm, sw, 1, scr, it, lane);
        else p0_quant_item(a.w_ffn2_in, a.g_ffn2, 2 * DFF, ws + WS_W2I, cm + 2 * DFF, sw + 2 * DFF, 1, scr, it - I_FI, lane);
    }
}
__device__ __forceinline__ void phase_quant(const Args& a, int G, int vcu) {
    const int tid = threadIdx.x, lane = tid & 63, wave = tid >> 6; unsigned char* ws = a.ws;
    for (int m = vcu * NWAVES + wave; m < T; m += G * NWAVES) quant_row_bf16((const bf16_t*)(ws + WS_HB) + (size_t)m * DM, ws + WS_AQ + (size_t)m * DM, (float*)(ws + WS_SCA) + m, lane);
}
__device__ __forceinline__ int crow(int r, int hi) { return (r & 3) + 8 * (r >> 2) + 4 * hi; }
__device__ __forceinline__ s16x4 vtr(const LAS unsigned char* p) { typedef short v4i16_t __attribute__((ext_vector_type(4))); return __builtin_bit_cast(s16x4, __builtin_amdgcn_ds_read_tr16_b64_v4i16((LAS v4i16_t*)p)); }
#define MFMA32(A, B, C) __builtin_amdgcn_mfma_f32_32x32x16_bf16((A), (B), (C), 0, 0, 0)
__device__ __forceinline__ f32x16 mfma32z(bf16x8 a, bf16x8 b) { f32x16 r = __builtin_amdgcn_mfma_f32_32x32x16_bf16(a, b, f32x16{}, 0, 0, 0); asm volatile("" : "+v"(r) : "v"(a), "v"(b)); return r; }
__device__ __forceinline__ void phase_swa(const Args& a, LAS unsigned char* lds, int G, int vcu) {
    const int tid = threadIdx.x, lane = tid & 63, r32 = lane & 31, hi = lane >> 5, wid = __builtin_amdgcn_readfirstlane(tid >> 6);
    unsigned char* ws = a.ws;
    const bf16_t* Q = (const bf16_t*)(ws + WS_Q); const bf16_t* Kg = (const bf16_t*)(ws + WS_K); const bf16_t* Vg = (const bf16_t*)(ws + WS_V);
    const bf16_t* GB = (const bf16_t*)(ws + WS_GB); const bf16_t* Z = (const bf16_t*)(ws + WS_Z); bf16_t* MX = (bf16_t*)(ws + WS_MIXED);
    LAS float* SSX = (LAS float*)(lds + XTRA_OFF);
    const float sink2 = a.sinks[wid] * LOG2E;
    const int kvh = wid >> 2;
    for (int unit = vcu; unit < NB * (SEQ / BLK); unit += G) {
        const int b = unit / (SEQ / BLK), blk = unit % (SEQ / BLK); const size_t t0 = (size_t)b * SEQ + (size_t)blk * BLK;
#pragma unroll
        for (int kh = 0; kh < 2; ++kh)
#pragma unroll
            for (int kt = 0; kt < 4; ++kt) {
                v4u kv = (v4u){0u, 0u, 0u, 0u}, vv = (v4u){0u, 0u, 0u, 0u};
                if (blk > 0 || kt >= 2) {
                    const size_t kr = t0 - 128 + 64 * kt;
                    kv = *(const v4u*)(Kg + (kr + lane) * KVW + kh * 64 + wid * 8);
                    vv = *(const v4u*)(Vg + (kr + 16 * (wid & 3) + (lane >> 2)) * KVW + kh * 64 + (wid >> 2) * 32 + (lane & 3) * 8);
                }
                *(LAS v4u*)(lds + (kh * 4 + kt) * 8192 + wid * 1024 + lane * 16) = kv;
                *(LAS v4u*)(lds + 65536 + (kh * 4 + kt) * 8192 + wid * 1024 + lane * 16) = vv;
            }
        __syncthreads();
#pragma unroll
        for (int half = 0; half < 2; ++half) {
        v2u opk[2][2][4];
#pragma unroll
        for (int q2 = 0; q2 < 2; ++q2) { const int qs = 2 * half + q2;
            const bf16_t* Qw = Q + (t0 + 32 * qs + r32) * AW + wid * 64;
            bf16x8 qr[4];
#pragma unroll
            for (int d0 = 0; d0 < 4; ++d0) qr[d0] = *(const bf16x8*)(Qw + d0 * 16 + hi * 8);
            const int T0 = qs >> 1;
            f32x16 p[3][2];
#pragma unroll
            for (int i = 0; i < 3; ++i) {
                const LAS unsigned char* kb = lds + (kvh * 4 + T0 + i) * 8192 + hi * 1024 + r32 * 16;
#pragma unroll
                for (int d0 = 0; d0 < 4; ++d0) {
                    const bf16x8 b0 = *(const LAS bf16x8*)(kb + d0 * 2048), b1 = *(const LAS bf16x8*)(kb + d0 * 2048 + 512);
                    if (d0 == 0) { p[i][0] = mfma32z(b0, qr[0]); p[i][1] = mfma32z(b1, qr[0]); }
                    else { p[i][0] = MFMA32(b0, qr[d0], p[i][0]); p[i][1] = MFMA32(b1, qr[d0], p[i][1]); }
                }
            }
            const int qi = 32 * qs + r32; float mx = sink2;
#pragma unroll
            for (int i = 0; i < 3; ++i)
#pragma unroll
                for (int h2 = 0; h2 < 2; ++h2)
#pragma unroll
                    for (int r = 0; r < 16; ++r) { const int ki = 64 * (T0 + i) + 32 * h2 + crow(r, hi);
                        const bool ok = (ki > qi) && (ki <= qi + 128) && (blk > 0 || ki >= 128);
                        const float s = ok ? p[i][h2][r] : -1e30f; p[i][h2][r] = s; mx = fmaxf(mx, s); }
            mx = fmaxf(mx, __shfl_xor(mx, 32));
            float l = 0.f;
#pragma unroll
            for (int i = 0; i < 3; ++i)
#pragma unroll
                for (int h2 = 0; h2 < 2; ++h2)
#pragma unroll
                    for (int r = 0; r < 16; ++r) { const float e = __builtin_amdgcn_exp2f(p[i][h2][r] - mx); p[i][h2][r] = e; l += e; }
            l += __shfl_xor(l, 32); l += __builtin_amdgcn_exp2f(sink2 - mx);
            const float rl = 1.0f / l;
            f32x16 oT[2];
#pragma unroll
            for (int i = 0; i < 3; ++i) {
                const LAS unsigned char* vp = lds + 65536 + (kvh * 4 + T0 + i) * 8192 + ((lane >> 4) & 1) * 32 + (lane & 3) * 8 + (4 * hi + ((lane & 15) >> 2)) * 64;
#pragma unroll
                for (int ks = 0; ks < 4; ++ks) {
                    const f32x16& ps = p[i][ks >> 1]; const int rb = (ks & 1) * 8;
                    v4u pw; pw.x = cvtpk(ps[rb + 0], ps[rb + 1]); pw.y = cvtpk(ps[rb + 2], ps[rb + 3]); pw.z = cvtpk(ps[rb + 4], ps[rb + 5]); pw.w = cvtpk(ps[rb + 6], ps[rb + 7]);
                    const bf16x8 pf = __builtin_bit_cast(bf16x8, pw);
#pragma unroll
                    for (int d0 = 0; d0 < 2; ++d0) {
                        const s16x4 lo = vtr(vp + d0 * 4096 + ks * 1024), hh = vtr(vp + d0 * 4096 + ks * 1024 + 512);
                        const bf16x8 vf = (bf16x8){lo[0], lo[1], lo[2], lo[3], hh[0], hh[1], hh[2], hh[3]};
                        if (i == 0 && ks == 0) oT[d0] = mfma32z(vf, pf); else oT[d0] = MFMA32(vf, pf, oT[d0]);
                    }
                }
            }
            float ss = 0.f;
#pragma unroll
            for (int d0 = 0; d0 < 2; ++d0)
#pragma unroll
                for (int r = 0; r < 16; ++r) { const float o = oT[d0][r] * rl; oT[d0][r] = o; ss += o * o; }
            ss += __shfl_xor(ss, 32);
            if (hi == 0) SSX[(32 * qs + r32) * 8 + wid] = ss;
#pragma unroll
            for (int d0 = 0; d0 < 2; ++d0)
#pragma unroll
                for (int g = 0; g < 4; ++g) { v2u w; w.x = cvtpk(oT[d0][4 * g], oT[d0][4 * g + 1]); w.y = cvtpk(oT[d0][4 * g + 2], oT[d0][4 * g + 3]); opk[q2][d0][g] = w; }
        }
        __syncthreads();
#pragma unroll
        for (int q2 = 0; q2 < 2; ++q2) { const int qs = 2 * half + q2;
            const f32x4 s0 = *(const LAS f32x4*)(SSX + (32 * qs + r32) * 8), s1 = *(const LAS f32x4*)(SSX + (32 * qs + r32) * 8 + 4);
            const float tot = ((s0[0] + s0[1]) + (s0[2] + s0[3])) + ((s1[0] + s1[1]) + (s1[2] + s1[3]));
            const float ra = __builtin_amdgcn_rsqf(tot * (1.0f / AW) + RMS_EPS);
            bf16_t* dst = MX + (t0 + 32 * qs + r32) * DM + wid * 64 + 4 * hi;
#pragma unroll
            for (int d0 = 0; d0 < 2; ++d0)
#pragma unroll
                for (int g = 0; g < 4; ++g) { const v2u w = opk[q2][d0][g]; v2u o;
                    o.x = cvtpk(bf2f(w.x) * ra, bf2f(w.x >> 16) * ra); o.y = cvtpk(bf2f(w.y) * ra, bf2f(w.y >> 16) * ra);
                    *(v2u*)(dst + 32 * d0 + 8 * g) = o; }
        }
        }
        {
            const int c0 = 8 * lane; float cw[3][8];
#pragma unroll
            for (int j = 0; j < 3; ++j) { const f32x4 w0 = *(const f32x4*)(a.conv_w + j * CW + c0), w1 = *(const f32x4*)(a.conv_w + j * CW + c0 + 4);
                cw[j][0] = w0[0]; cw[j][1] = w0[1]; cw[j][2] = w0[2]; cw[j][3] = w0[3]; cw[j][4] = w1[0]; cw[j][5] = w1[1]; cw[j][6] = w1[2]; cw[j][7] = w1[3]; }
            const size_t tw = t0 + 16 * wid; const int s0 = blk * BLK + 16 * wid;
            v4u z2 = (v4u){0u, 0u, 0u, 0u}, z1 = (v4u){0u, 0u, 0u, 0u};
            if (s0 >= 2) z2 = *(const v4u*)(Z + (tw - 2) * CW + c0);
            if (s0 >= 1) z1 = *(const v4u*)(Z + (tw - 1) * CW + c0);
            for (int tt = 0; tt < 16; ++tt) {
                const v4u z0 = *(const v4u*)(Z + (tw + tt) * CW + c0), gb = *(const v4u*)(GB + (tw + tt) * CW + c0);
                float y[8]; float ss = 0.f;
#pragma unroll
                for (int e = 0; e < 4; ++e) {
                    const unsigned a2 = z2[e], a1 = z1[e], a0 = z0[e], gg = gb[e];
                    const float ylo = (cw[0][2 * e] * bf2f(a2) + cw[1][2 * e] * bf2f(a1) + cw[2][2 * e] * bf2f(a0)) * bf2f(gg);
                    const float yhi = (cw[0][2 * e + 1] * bf2f(a2 >> 16) + cw[1][2 * e + 1] * bf2f(a1 >> 16) + cw[2][2 * e + 1] * bf2f(a0 >> 16)) * bf2f(gg >> 16);
                    y[2 * e] = ylo; y[2 * e + 1] = yhi; ss += ylo * ylo + yhi * yhi;
                }
                ss = wave_sum(ss); const float rc = __builtin_amdgcn_rsqf(ss * (1.0f / CW) + RMS_EPS);
                v4u o; o.x = cvtpk(y[0] * rc, y[1] * rc); o.y = cvtpk(y[2] * rc, y[3] * rc); o.z = cvtpk(y[4] * rc, y[5] * rc); o.w = cvtpk(y[6] * rc, y[7] * rc);
                *(v4u*)(MX + (tw + tt) * DM + AW + c0) = o;
                z2 = z1; z1 = z0;
            }
        }
        __syncthreads();
    }
}
__device__ __forceinline__ void phase_xattn(const Args& a, LAS unsigned char* lds, int G, int vcu) {
    const int tid0 = threadIdx.x, wid = __builtin_amdgcn_readfirstlane(tid0 >> 6);
    unsigned char* ws = a.ws;
    const bf16_t* XQ = (const bf16_t*)(ws + WS_XQ); const bf16_t* KVM = (const bf16_t*)(ws + WS_KVM); bf16_t* XO = (bf16_t*)(ws + WS_XO);
    for (int unit = vcu; unit < (T / 256) * XH; unit += G) {
        int tid = tid0; asm volatile("" : "+v"(tid));
        const int lane = tid & 63, r32 = lane & 31, hi = lane >> 5;
        const int pm = unit / XH, h = unit % XH; const size_t t0 = (size_t)pm * 256; const int b = (int)(t0 / SEQ);
        const bf16_t* Kh = KVM + (size_t)(b * MEML) * 2 * DM + h * XHD; const bf16_t* Vh = Kh + DM;
        {   const int mq = tid >> 5, c = tid & 31;
            const unsigned loff = (unsigned)(mq * (2 * DM * 2) + c * 16);
            LAS unsigned char* d0p = lds + mq * 512 + ((c ^ mq) << 4); LAS unsigned char* d1p = lds + mq * 512 + (((c ^ mq) ^ 16) << 4);
#pragma unroll
            for (int i = 0; i < 16; ++i) { GAS const char* bp = (GAS const char*)Kh + (size_t)i * (16 * 2 * DM * 2); asm("" : "+s"(bp)); const v4u v = *(GAS const v4u*)(bp + loff); *(LAS v4u*)(((i & 1) ? d1p : d0p) + i * 8192) = v; } }
        const bf16_t* Qw = XQ + (t0 + 32 * wid + r32) * DM + h * XHD + hi * 8;
        __syncthreads();
        v4u pw[16]; float l = 0.f, m_run = -1e30f, f0 = 1.0f;
#pragma unroll
        for (int ps = 0; ps < 2; ++ps) {
            __builtin_amdgcn_sched_barrier(0);
            bf16x8 qc[4], qn[4];
#pragma unroll
            for (int dd = 0; dd < 4; ++dd) qc[dd] = *(const bf16x8*)(Qw + dd * 16);
            f32x16 p[4];
#pragma unroll
            for (int g = 0; g < 4; ++g) {
                if (g < 3) {
#pragma unroll
                    for (int dd = 0; dd < 4; ++dd) qn[dd] = *(const bf16x8*)(Qw + (4 * g + 4 + dd) * 16);
                }
#pragma unroll
                for (int dd = 0; dd < 4; ++dd) {
                    const int d0 = 4 * g + dd; unsigned ab = (unsigned)(ps * 65536 + r32 * 512 + (((2 * d0 + hi) ^ r32) << 4));
                    asm volatile("" : "+v"(ab));
#pragma unroll
                    for (int j = 0; j < 4; ++j) { const bf16x8 kf = *(const LAS bf16x8*)(lds + ab + j * 16384); if (d0 == 0) p[j] = mfma32z(kf, qc[0]); else p[j] = MFMA32(kf, qc[dd], p[j]); }
                }
                __builtin_amdgcn_sched_barrier(0);
#pragma unroll
                for (int dd = 0; dd < 4; ++dd) qc[dd] = qn[dd];
            }
            __builtin_amdgcn_sched_barrier(0);
            float mx = -1e30f;
#pragma unroll
            for (int j = 0; j < 4; ++j)
#pragma unroll
                for (int r = 0; r < 16; ++r) mx = fmaxf(mx, p[j][r]);
            mx = fmaxf(mx, __shfl_xor(mx, 32));
            const float mnew = fmaxf(m_run, mx);
            if (ps == 1) { f0 = __builtin_amdgcn_exp2f(m_run - mnew); l *= f0; }
            m_run = mnew;
            float ls = 0.f;
#pragma unroll
            for (int j = 0; j < 4; ++j) {
#pragma unroll
                for (int r = 0; r < 16; ++r) { const float e = __builtin_amdgcn_exp2f(p[j][r] - mnew); p[j][r] = e; ls += e; }
                v4u w0, w1;
                w0.x = cvtpk(p[j][0], p[j][1]); w0.y = cvtpk(p[j][2], p[j][3]); w0.z = cvtpk(p[j][4], p[j][5]); w0.w = cvtpk(p[j][6], p[j][7]);
                w1.x = cvtpk(p[j][8], p[j][9]); w1.y = cvtpk(p[j][10], p[j][11]); w1.z = cvtpk(p[j][12], p[j][13]); w1.w = cvtpk(p[j][14], p[j][15]);
                pw[8 * ps + 2 * j] = w0; pw[8 * ps + 2 * j + 1] = w1;
                __builtin_amdgcn_sched_barrier(0);
            }
            l += ls;
            __builtin_amdgcn_sched_barrier(0);
        }
        l += __shfl_xor(l, 32); const float rl = 1.0f / l;
        __syncthreads();
        {   const int mq = tid >> 5, c = tid & 31;
            const unsigned loff = (unsigned)(mq * (2 * DM * 2) + c * 16); LAS unsigned char* dp = lds + (c >> 2) * 16384 + mq * 64 + (c & 3) * 16;
#pragma unroll
            for (int i = 0; i < 16; ++i) { GAS const char* bp = (GAS const char*)Vh + (size_t)i * (16 * 2 * DM * 2); asm("" : "+s"(bp)); const v4u v = *(GAS const v4u*)(bp + loff); *(LAS v4u*)(dp + i * 1024) = v; } }
        __syncthreads();
        const LAS unsigned char* vp = lds + ((lane >> 4) & 1) * 32 + (lane & 3) * 8 + (4 * hi + ((lane & 15) >> 2)) * 64;
        bf16_t* dst = XO + (t0 + 32 * wid + r32) * DM + h * XHD + 4 * hi;
#pragma unroll
        for (int db = 0; db < 8; ++db) {
            f32x16 o;
            unsigned vb = (unsigned)(db * 16384); asm volatile("" : "+v"(vb));
#pragma unroll
            for (int ks = 0; ks < 16; ++ks) {
                const s16x4 lo = vtr(vp + vb + ks * 1024), hh = vtr(vp + vb + ks * 1024 + 512);
                const bf16x8 vf = (bf16x8){lo[0], lo[1], lo[2], lo[3], hh[0], hh[1], hh[2], hh[3]};
                if (ks == 0) o = mfma32z(vf, __builtin_bit_cast(bf16x8, pw[0])); else o = MFMA32(vf, __builtin_bit_cast(bf16x8, pw[ks]), o);
                if (ks == 7) {
#pragma unroll
                    for (int r = 0; r < 16; ++r) o[r] *= f0;
                }
            }
#pragma unroll
            for (int g = 0; g < 4; ++g) { v2u w; w.x = cvtpk(o[4 * g] * rl, o[4 * g + 1] * rl); w.y = cvtpk(o[4 * g + 2] * rl, o[4 * g + 3] * rl); *(v2u*)(dst + 32 * db + 8 * g) = w; }
        }
        __syncthreads();
    }
}
__device__ __forceinline__ void phase_final(const Args& a, int G, int vcu) {
    const int tid = threadIdx.x, lane = tid & 63, wave = tid >> 6;
    const float* ssp = (const float*)(a.ws + ws_ss(4)); const bf16_t* HB = (const bf16_t*)(a.ws + WS_HB);
    f32x4 gv[4];
#pragma unroll
    for (int j = 0; j < 2; ++j) { gv[2 * j] = *(const f32x4*)(a.g_final + 512 * j + 8 * lane); gv[2 * j + 1] = *(const f32x4*)(a.g_final + 512 * j + 8 * lane + 4); }
    for (int m = vcu * NWAVES + wave; m < T; m += G * NWAVES) {
        const f32x4 p0 = *(const f32x4*)(ssp + (size_t)m * 16), p1 = *(const f32x4*)(ssp + (size_t)m * 16 + 4), p2 = *(const f32x4*)(ssp + (size_t)m * 16 + 8), p3 = *(const f32x4*)(ssp + (size_t)m * 16 + 12);
        const float s = (((p0[0] + p0[1]) + (p0[2] + p0[3])) + ((p1[0] + p1[1]) + (p1[2] + p1[3]))) + (((p2[0] + p2[1]) + (p2[2] + p2[3])) + ((p3[0] + p3[1]) + (p3[2] + p3[3])));
        const float r = 1.0f / sqrtf(s * (1.0f / DM) + RMS_EPS);
#pragma unroll
        for (int j = 0; j < 2; ++j) { const v4u hv = *(const v4u*)(HB + (size_t)m * DM + 512 * j + 8 * lane);
            f32x4 o0 = (f32x4){bf2f(hv.x), bf2f(hv.x >> 16), bf2f(hv.y), bf2f(hv.y >> 16)}, o1 = (f32x4){bf2f(hv.z), bf2f(hv.z >> 16), bf2f(hv.w), bf2f(hv.w >> 16)};
            o0 = o0 * r * gv[2 * j]; o1 = o1 * r * gv[2 * j + 1];
            float* op = a.out + (size_t)m * DM + 512 * j + 8 * lane; *(f32x4*)op = o0; *(f32x4*)(op + 4) = o1; }
    }
}
#define XB_TMO      128
#define XB_XCNT(j)  (256  + 64 * (j))
#define XB_XSUB(j)  (1280 + 64 * (j))
#define XB_XGEN(j)  (2304 + 64 * (j))
#define XB_TOP      3328
#define XB_TOPGEN   3392
#define XCD_BAR_WORDS 3456
#define XB_SPIN_CAP (1u << 18)

__device__ __forceinline__ unsigned xb_ld(unsigned* p)              { return __hip_atomic_load(p, __ATOMIC_RELAXED, __HIP_MEMORY_SCOPE_AGENT); }
__device__ __forceinline__ unsigned xb_add(unsigned* p, unsigned v) { return __hip_atomic_fetch_add(p, v, __ATOMIC_RELAXED, __HIP_MEMORY_SCOPE_AGENT); }
__device__ __forceinline__ unsigned xb_xcc_id() { return (unsigned)__builtin_amdgcn_s_getreg((3 << 11) | 20) & 0xFu; }
#define XB_SPIN(cond, bar) do { unsigned _sp = 0; while (cond) { __builtin_amdgcn_s_sleep(1); \
    if ((++_sp & 255u) == 0u) { if (xb_ld(&(bar)[XB_TMO])) break; if (_sp > XB_SPIN_CAP) { atomicAdd(&(bar)[XB_TMO], 1u); break; } } } } while (0)

struct XcdBarrier {
    unsigned* bar; unsigned x;
    volatile LAS unsigned* st;
};

__device__ __forceinline__ XcdBarrier xcd_barrier_post(unsigned* bar, volatile LAS unsigned* st) {
    XcdBarrier b; b.bar = bar; b.x = xb_xcc_id(); b.st = st;
    if (threadIdx.x == 0) (void)xb_add(&bar[XB_XCNT(b.x)], 1u);
    return b;
}
__device__ __forceinline__ void xcd_barrier_complete(unsigned* bar, unsigned x, unsigned& nloc, unsigned& nx) {
    const unsigned G = gridDim.x * gridDim.y * gridDim.z;
    unsigned sum, cnt, mine, sp = 0u;
    for (;;) {
        sum = 0u; cnt = 0u; mine = 0u;
#pragma unroll
        for (unsigned j = 0; j < 16; ++j) { const unsigned c = xb_ld(&bar[XB_XCNT(j)]); sum += c; cnt += (c > 0u) ? 1u : 0u; mine = (j == x) ? c : mine; }
        if (sum == G) break;
        __builtin_amdgcn_s_sleep(1);
        if ((++sp & 255u) == 0u) { if (xb_ld(&bar[XB_TMO])) break; if (sp > XB_SPIN_CAP) { atomicAdd(&bar[XB_TMO], 1u); break; } }
    }
    nloc = mine > 0u ? mine : 1u; nx = cnt > 0u ? cnt : 1u;
}

__device__ __forceinline__ void xcd_barrier(const XcdBarrier& b) {
    asm volatile("s_waitcnt vmcnt(0)" ::: "memory");
    __syncthreads();
    if (threadIdx.x == 0) {
        unsigned* bar = b.bar;
        __builtin_amdgcn_s_waitcnt(0);
        unsigned nloc = b.st[0], nx = b.st[1];
        if (nloc == 0u) { xcd_barrier_complete(bar, b.x, nloc, nx); b.st[0] = nloc; b.st[1] = nx; }
        const unsigned old = xb_add(&bar[XB_XSUB(b.x)], 1u);
        const unsigned gen = old / nloc;
        if (old + 1u == (gen + 1u) * nloc) {
            __builtin_amdgcn_fence(__ATOMIC_RELEASE, "agent");
            asm volatile("s_waitcnt vmcnt(0)" ::: "memory");
            const unsigned og = xb_add(&bar[XB_TOP], 1u);
            const unsigned tg = og / nx;
            if (og + 1u == (tg + 1u) * nx) xb_add(&bar[XB_TOPGEN], 1u);
            else XB_SPIN(xb_ld(&bar[XB_TOPGEN]) == tg, bar);
            __builtin_amdgcn_fence(__ATOMIC_ACQUIRE, "agent");
            xb_add(&bar[XB_XGEN(b.x)], 1u);
            asm volatile("s_waitcnt vmcnt(0)" ::: "memory");
        } else {
            XB_SPIN(xb_ld(&bar[XB_XGEN(b.x)]) == gen, bar);
            __builtin_amdgcn_fence(__ATOMIC_ACQUIRE, "agent");
            asm volatile("s_waitcnt vmcnt(0)" ::: "memory");
        }
    }
    __syncthreads();
}

#define GEMM_PHASE(EPI, SCHED, g, S, E) pg8::gemm_phase<EPI, SCHED, true, true>(lds, g, S, E)
__device__ __forceinline__ void ph_ffn_in(LAS unsigned char* lds, unsigned char* ws, int G, int bx, size_t wofs, int which) {
    pg8::Gemm g{(const bf16_t*)(ws + WS_AQ), (const bf16_t*)(ws + wofs), T, 2 * DFF, DM / 2}; pg8::StaticOrder S; S.init(T, 2 * DFF, G, bx);
    pg8::EpiSwiGLU8 E{(bf16_t*)(ws + WS_G), (const float*)(ws + WS_SCA), (const float*)(ws + WS_SW) + which * 2 * DFF};
    GEMM_PHASE(pg8::EpiSwiGLU8, pg8::StaticOrder, g, S, E);
}
template <bool F32IN> __device__ __forceinline__ void ph_resid(LAS unsigned char* lds, unsigned char* ws, int G, int bx, size_t aofs, size_t wofs, int K, const float* hin32, int sso, float w) {
    pg8::Gemm g{(const bf16_t*)(ws + aofs), (const bf16_t*)(ws + wofs), T, DM, K}; pg8::StaticOrder S; S.init(T, DM, G, bx);
    pg8::EpiResid<F32IN> E{hin32, (bf16_t*)(ws + WS_HB), (float*)(ws + ws_ss(sso)), w};
    GEMM_PHASE(pg8::EpiResid<F32IN>, pg8::StaticOrder, g, S, E);
}
__device__ __forceinline__ void ph_mix_in(LAS unsigned char* lds, unsigned char* ws, int G, int bx) {
    { pg8::Gemm g{(const bf16_t*)(ws + WS_HB), (const bf16_t*)(ws + WS_WMI), T, INC, DM}; pg8::StaticOrder S; S.init(T, INC, G, bx);
      pg8::EpiMixIn E{(const float*)(ws + ws_ss(1)), (const float*)(ws + WS_ROPE), (bf16_t*)(ws + WS_Q), (bf16_t*)(ws + WS_K), (bf16_t*)(ws + WS_V), (bf16_t*)(ws + WS_GB), (bf16_t*)(ws + WS_Z)};
      GEMM_PHASE(pg8::EpiMixIn, pg8::StaticOrder, g, S, E); }
    { int idx0, cnt;
      if (G == 256) { idx0 = bx - 128; cnt = (bx >= 128 && bx < 160) ? 1 : 0; }
      else { const int per = (32 + G - 1) / G; idx0 = bx * per; cnt = idx0 >= 32 ? 0 : (idx0 + per <= 32 ? per : 32 - idx0); }
      pg8::ListOrder S{idx0, cnt, 8};
      pg8::Gemm g{(const bf16_t*)(ws + WS_MEMB), (const bf16_t*)(ws + WS_WXKV), MROWS, 2 * DM, DM};
      pg8::EpiScale E{(bf16_t*)(ws + WS_KVM), 2 * DM, (const float*)(ws + WS_SSMEM), 1.0f};
      GEMM_PHASE(pg8::EpiScale, pg8::ListOrder, g, S, E); }
}
__device__ __forceinline__ void ph_xq(LAS unsigned char* lds, unsigned char* ws, int G, int bx) {
    pg8::Gemm g{(const bf16_t*)(ws + WS_HB), (const bf16_t*)(ws + WS_WXQ), T, DM, DM}; pg8::StaticOrder S; S.init(T, DM, G, bx);
    pg8::EpiScale E{(bf16_t*)(ws + WS_XQ), DM, (const float*)(ws + ws_ss(2)), XSCALE};
    GEMM_PHASE(pg8::EpiScale, pg8::StaticOrder, g, S, E);
}
#ifndef PHMASK
#define PHMASK 0x3FFF
#endif
#ifndef REPEAT_PH
#define REPEAT_PH -1
#endif
__global__ void __launch_bounds__(NTHR, 2) mk_fwd(Args a) {
    extern __shared__ __attribute__((aligned(16))) unsigned char lds_raw[];
    LAS unsigned char* lds = (LAS unsigned char*)lds_raw;
    const int G = gridDim.x, bx = blockIdx.x, vcu = (G % 8 == 0) ? (bx % 8) * (G / 8) + bx / 8 : bx;
    unsigned char* ws = a.ws;
    const int lo = a.ph_lo, hi = a.ph_hi;
#define IN(k) (((PHMASK >> (k)) & 1) && lo <= (k) && (k) < hi)
    volatile LAS unsigned* bst = (volatile LAS unsigned*)(lds + XTRA_OFF + 8192);
    if (threadIdx.x < 2) bst[threadIdx.x] = 0u;
    __syncthreads();
    if (lo < 0) cg::this_grid().sync();
    XcdBarrier bar = xcd_barrier_post((unsigned*)(ws + WS_CTL), bst);
#define SEAM(k) do { if (IN(k) && IN((k) + 1)) xcd_barrier(bar); } while (0)
#define RUN(k, CALL) do { if (IN(k)) { CALL; if (REPEAT_PH == (k)) { xcd_barrier(bar); CALL; } } } while (0)
#ifdef EXTRA_SYNCS
    if (lo > 100) for (int i = 0; i < EXTRA_SYNCS; ++i) cg::this_grid().sync();
#endif
    RUN(0, phase_prep(a, lds, G, vcu));
    SEAM(0);
#ifdef EXTRA_SYNCS
    for (int i = 0; i < EXTRA_SYNCS; ++i) xcd_barrier(bar);
#endif
    RUN(1, phase_prep_b(a, lds, G, vcu));
    SEAM(1);
    RUN(2, ph_ffn_in(lds, ws, G, bx, WS_W1I, 0));
    SEAM(2);
    RUN(3, ph_resid<true>(lds, ws, G, bx, WS_G, WS_W1O, DFF, a.x, 1, 0.5f));
    SEAM(3);
    RUN(4, ph_mix_in(lds, ws, G, bx));
    SEAM(4);
    RUN(5, phase_swa(a, lds, G, vcu));
    SEAM(5);
    RUN(6, ph_resid<false>(lds, ws, G, bx, WS_MIXED, WS_WMO, DM, nullptr, 2, 1.0f));
    SEAM(6);
    RUN(7, ph_xq(lds, ws, G, bx));
    SEAM(7);
    RUN(8, phase_xattn(a, lds, G, vcu));
    SEAM(8);
    RUN(9, ph_resid<false>(lds, ws, G, bx, WS_XO, WS_WXO, DM, nullptr, 3, 1.0f));
    SEAM(9);
    RUN(10, phase_quant(a, G, vcu));
    SEAM(10);
    RUN(11, ph_ffn_in(lds, ws, G, bx, WS_W2I, 1));
    SEAM(11);
    RUN(12, ph_resid<false>(lds, ws, G, bx, WS_G, WS_W2O, DFF, nullptr, 4, 0.5f));
    SEAM(12);
    RUN(13, phase_final(a, G, vcu));
#undef IN
#undef SEAM
#undef RUN
}
static void fill_args(Args& a, void* const* d_in, void* d_out, void* d_ws) {
    a.x = (const float*)d_in[0]; a.mem = (const float*)d_in[1]; a.pos = (const int*)d_in[2]; a.g_ffn1 = (const float*)d_in[3]; a.w_ffn1_in = (const float*)d_in[4]; a.w_ffn1_out = (const float*)d_in[5];
    a.g_mix = (const float*)d_in[6]; a.w_mix_in = (const float*)d_in[7]; a.sinks = (const float*)d_in[8]; a.conv_w = (const float*)d_in[9]; a.g_attn_out = (const float*)d_in[10]; a.g_conv_out = (const float*)d_in[11];
    a.w_mix_out = (const float*)d_in[12]; a.g_mem = (const float*)d_in[13]; a.g_xattn = (const float*)d_in[14]; a.w_xq = (const float*)d_in[15]; a.w_xkv = (const float*)d_in[16]; a.w_xo = (const float*)d_in[17];
    a.g_ffn2 = (const float*)d_in[18]; a.w_ffn2_in = (const float*)d_in[19]; a.w_ffn2_out = (const float*)d_in[20]; a.g_final = (const float*)d_in[21];
    a.out = (float*)d_out; a.ws = (unsigned char*)d_ws;
}
extern "C" void kernel_launch(void* const* d_in, const int* in_sizes, int n_in, void* d_out, int out_size, void* d_ws, size_t ws_size, hipStream_t stream) {
    if (n_in != 22 || out_size != T * DM || ws_size < WS_END) { fprintf(stderr, "kernel_launch: unexpected shapes (n_in %d out %d ws %zu)\n", n_in, out_size, ws_size); return; }
    static int grid = 0;
    if (grid == 0) {
        int dev = 0, cus = 0, per_cu = 0;
        if (hipFuncSetAttribute((const void*)mk_fwd, hipFuncAttributeMaxDynamicSharedMemorySize, LDS_BYTES) != hipSuccess) { fprintf(stderr, "kernel_launch: hipFuncSetAttribute failed\n"); grid = -1; return; }
        if (hipGetDevice(&dev) != hipSuccess || hipDeviceGetAttribute(&cus, hipDeviceAttributeMultiprocessorCount, dev) != hipSuccess) { fprintf(stderr, "kernel_launch: device query failed\n"); grid = -1; return; }
        if (hipOccupancyMaxActiveBlocksPerMultiprocessor(&per_cu, (const void*)mk_fwd, NTHR, LDS_BYTES) != hipSuccess || per_cu < 1) { fprintf(stderr, "kernel_launch: occupancy query says %d blocks per CU\n", per_cu); grid = -1; return; }
        grid = cus;
    }
    if (grid < 0) return;
    if (hipMemsetAsync((char*)d_ws + WS_CTL, 0, 65536, stream) != hipSuccess) { fprintf(stderr, "kernel_launch: hipMemsetAsync failed\n"); return; }
    Args a{}; fill_args(a, d_in, d_out, d_ws); a.ph_lo = 0; a.ph_hi = NPH;
    void* args[] = {&a};
    const hipError_t e = hipLaunchCooperativeKernel((const void*)mk_fwd, dim3(grid), dim3(NTHR), args, LDS_BYTES, stream);
    if (e != hipSuccess) fprintf(stderr, "kernel_launch: cooperative launch failed: %s (grid %d)\n", hipGetErrorString(e), grid);
}
```
